# Optimizing an MI355X kernel written in HIP

```python
import jax, jax.numpy as jnp
from jax import lax
import numpy as np

D_MODEL = 1024
BATCH = 2
SEQ = 16384
DEPTH = 2

MIX_WIDTH = D_MODEL
CONV_WIDTH = MIX_WIDTH // 2
CONV_GROUPS = 4
CONV_WIN = 31
DN_WIDTH = MIX_WIDTH - CONV_WIDTH
DN_HEADS = 4
DN_HEAD_DIM = DN_WIDTH // DN_HEADS
SHORT_CONV = 4
CHUNK = 64
D_FF_DENSE = 2816
N_EXPERTS = 8
TOP_K = 2
D_FF_EXPERT = 3584
N_DENSE = (DEPTH + 1) // 2
N_MOE = DEPTH // 2
DEEPNORM_ALPHA = (2 * DEPTH) ** 0.25
DEEPNORM_BETA = (8 * DEPTH) ** -0.25
LN_EPS = 1e-5
RMS_EPS = 1e-6
L2_EPS = 1e-6
IN_SIZES = (CONV_WIDTH, CONV_WIDTH, DN_WIDTH, DN_WIDTH, DN_WIDTH, DN_WIDTH, DN_HEADS, DN_HEADS)
IN_COLS = sum(IN_SIZES)
IN_SPLITS = tuple(int(s) for s in np.cumsum(IN_SIZES)[:-1])

kernel_name = "hybrid_conformer_deltanet_deepnorm_moe"


def layer_norm(x, g, b):
    xf = x.astype(jnp.float32)
    mu = xf.mean(-1, keepdims=True)
    var = jnp.square(xf - mu).mean(-1, keepdims=True)
    return ((xf - mu) * lax.rsqrt(var + LN_EPS) * g + b).astype(x.dtype)


def causal_depthwise_conv(x, w):
    width = w.shape[0]
    return lax.conv_general_dilated(
        x, w[:, None, :].astype(x.dtype), (1,), ((width - 1, 0),),
        dimension_numbers=("NWC", "WIO", "NWC"), feature_group_count=x.shape[-1])


def conformer_conv(h_val, h_gate, dw_w, dw_b, ln_g, ln_b):
    h = h_val * jax.nn.sigmoid(h_gate)
    h = causal_depthwise_conv(h, dw_w) + dw_b
    h = layer_norm(h, ln_g, ln_b)
    return jax.nn.silu(h)


def l2norm(t):
    return t * lax.rsqrt(jnp.sum(t * t, -1, keepdims=True) + L2_EPS)


def chunk_gated_delta_rule(q, k, v, g, beta):
    B, S, H, Dk = q.shape
    Dv = v.shape[-1]
    N = S // CHUNK
    q = q * (Dk ** -0.5)
    to_chunks = lambda t: t.reshape(B, N, CHUNK, H, t.shape[-1]).transpose(0, 3, 1, 2, 4)
    q, k, v = to_chunks(q), to_chunks(k), to_chunks(v)
    g = g.reshape(B, N, CHUNK, H).transpose(0, 3, 1, 2)
    beta = beta.reshape(B, N, CHUNK, H).transpose(0, 3, 1, 2)
    g = jnp.cumsum(g, axis=-1)
    kb = k * beta[..., None]
    vb = v * beta[..., None]
    causal = jnp.tril(jnp.ones((CHUNK, CHUNK), bool))
    strict = jnp.tril(jnp.ones((CHUNK, CHUNK), bool), -1)
    decay = jnp.exp(jnp.where(causal, g[..., :, None] - g[..., None, :], -jnp.inf))
    lower = jnp.where(strict, jnp.einsum('bhncd,bhnjd->bhncj', kb, k) * decay, 0.0)
    eye = jnp.eye(CHUNK, dtype=jnp.float32)
    rhs = jnp.concatenate([vb, kb * jnp.exp(g)[..., None]], axis=-1)
    sol = lax.linalg.triangular_solve(eye + lower, rhs, left_side=True, lower=True, unit_diagonal=True)
    u, w = sol[..., :Dv], sol[..., Dv:]
    attn = jnp.einsum('bhncd,bhnjd->bhncj', q, k) * decay

    def step(state, inp):
        qc, kc, uc, wc, gc, ac = inp
        v_new = uc - jnp.einsum('bhcd,bhde->bhce', wc, state)
        o = jnp.einsum('bhcd,bhde->bhce', qc * jnp.exp(gc)[..., None], state) \
            + jnp.einsum('bhcj,bhje->bhce', ac, v_new)
        g_last = gc[..., -1]
        k_dec = kc * jnp.exp(g_last[..., None] - gc)[..., None]
        state = state * jnp.exp(g_last)[..., None, None] + jnp.einsum('bhcd,bhce->bhde', k_dec, v_new)
        return state, o

    lead = lambda t: jnp.moveaxis(t, 2, 0)
    s0 = jnp.zeros((B, H, Dk, Dv), jnp.float32)
    _, o = lax.scan(step, s0, (lead(q), lead(k), lead(u), lead(w), lead(g), lead(attn)))
    o = jnp.moveaxis(o, 0, 2)
    return o.transpose(0, 2, 3, 1, 4).reshape(B, S, H, Dv)


def gated_deltanet(q, k, v, z, b_logit, a_logit, sc_w, a_log, dt_bias, on_g):
    B, S, _ = q.shape
    qkv = jax.nn.silu(causal_depthwise_conv(jnp.concatenate([q, k, v], -1), sc_w))
    q, k, v = jnp.split(qkv, 3, axis=-1)
    heads = lambda t: t.reshape(B, S, DN_HEADS, DN_HEAD_DIM).astype(jnp.float32)
    q, k, v = l2norm(heads(q)), l2norm(heads(k)), heads(v)
    beta = jax.nn.sigmoid(b_logit.astype(jnp.float32))
    g = -jnp.exp(a_log.astype(jnp.float32)) * jax.nn.softplus(
        a_logit.astype(jnp.float32) + dt_bias.astype(jnp.float32))
    o = chunk_gated_delta_rule(q, k, v, g, beta)
    o = o * lax.rsqrt(jnp.mean(o * o, -1, keepdims=True) + RMS_EPS) * on_g.astype(jnp.float32)
    o = o * jax.nn.silu(heads(z))
    return o.reshape(B, S, DN_WIDTH).astype(z.dtype)


def hybrid_mixer(x, w_in, dw_w, dw_b, cln_g, cln_b, sc_w, a_log, dt_bias, on_g, w_out):
    h = x @ w_in
    c_val, c_gate, q, k, v, z, b_logit, a_logit = jnp.split(h, IN_SPLITS, axis=-1)
    y_conv = conformer_conv(c_val, c_gate, dw_w, dw_b, cln_g, cln_b)
    y_dn = gated_deltanet(q, k, v, z, b_logit, a_logit, sc_w, a_log, dt_bias, on_g)
    return jnp.concatenate([y_conv, y_dn], axis=-1) @ w_out


def swiglu(x, w_gate, w_up, w_down):
    return (jax.nn.silu(x @ w_gate) * (x @ w_up)) @ w_down


def moe_swiglu(x, router_w, w_gate, w_up, w_down):
    logits = (x @ router_w).astype(jnp.float32)
    top_v, top_i = lax.top_k(logits, TOP_K)
    gates = jax.nn.softmax(top_v, axis=-1)
    combine = jnp.sum(jax.nn.one_hot(top_i, N_EXPERTS, dtype=jnp.float32) * gates[..., None], axis=-2)
    y = jnp.zeros_like(x)
    for e in range(N_EXPERTS):
        y = y + combine[..., e:e + 1].astype(x.dtype) * swiglu(x, w_gate[e], w_up[e], w_down[e])
    return y


def setup_inputs(seed: int = 0) -> dict:
    key = jax.random.key(seed)
    ks = jax.random.split(key, 24)
    f32 = jnp.float32
    nrm = lambda k, shape, scale: jax.random.normal(k, shape, f32) * scale
    dt = jnp.exp(jax.random.uniform(ks[8], (DEPTH, DN_HEADS), f32, np.log(1e-3), np.log(1e-1)))
    return {
        "x": nrm(ks[0], (BATCH, SEQ, D_MODEL), 1.0),
        "w_in": nrm(ks[1], (DEPTH, D_MODEL, IN_COLS), D_MODEL ** -0.5),
        "conv_dw_w": nrm(ks[2], (DEPTH, CONV_WIN, CONV_WIDTH), CONV_WIN ** -0.5),
        "conv_dw_b": nrm(ks[3], (DEPTH, CONV_WIDTH), 0.02),
        "conv_ln_g": 1.0 + nrm(ks[4], (DEPTH, CONV_WIDTH), 0.02),
        "conv_ln_b": nrm(ks[5], (DEPTH, CONV_WIDTH), 0.02),
        "short_conv_w": nrm(ks[6], (DEPTH, SHORT_CONV, 3 * DN_WIDTH), SHORT_CONV ** -0.5),
        "a_log": jnp.log(jax.random.uniform(ks[7], (DEPTH, DN_HEADS), f32, 1.0, 16.0)),
        "dt_bias": dt + jnp.log(-jnp.expm1(-dt)),
        "out_norm_g": 1.0 + nrm(ks[9], (DEPTH, DN_HEAD_DIM), 0.02),
        "w_out": nrm(ks[10], (DEPTH, MIX_WIDTH, D_MODEL), MIX_WIDTH ** -0.5 * DEEPNORM_BETA),
        "ln_mix_g": 1.0 + nrm(ks[11], (DEPTH, D_MODEL), 0.02),
        "ln_mix_b": nrm(ks[12], (DEPTH, D_MODEL), 0.02),
        "ffn_w_gate": nrm(ks[13], (N_DENSE, D_MODEL, D_FF_DENSE), D_MODEL ** -0.5),
        "ffn_w_up": nrm(ks[14], (N_DENSE, D_MODEL, D_FF_DENSE), D_MODEL ** -0.5),
        "ffn_w_down": nrm(ks[15], (N_DENSE, D_FF_DENSE, D_MODEL), D_FF_DENSE ** -0.5 * DEEPNORM_BETA),
        "router_w": nrm(ks[16], (N_MOE, D_MODEL, N_EXPERTS), D_MODEL ** -0.5),
        "moe_w_gate": nrm(ks[17], (N_MOE, N_EXPERTS, D_MODEL, D_FF_EXPERT), D_MODEL ** -0.5),
        "moe_w_up": nrm(ks[18], (N_MOE, N_EXPERTS, D_MODEL, D_FF_EXPERT), D_MODEL ** -0.5),
        "moe_w_down": nrm(ks[19], (N_MOE, N_EXPERTS, D_FF_EXPERT, D_MODEL), D_FF_EXPERT ** -0.5 * DEEPNORM_BETA),
        "ln_ffn_g": 1.0 + nrm(ks[20], (DEPTH, D_MODEL), 0.02),
        "ln_ffn_b": nrm(ks[21], (DEPTH, D_MODEL), 0.02),
    }


def reference(x, w_in, conv_dw_w, conv_dw_b, conv_ln_g, conv_ln_b, short_conv_w, a_log, dt_bias,
              out_norm_g, w_out, ln_mix_g, ln_mix_b, ffn_w_gate, ffn_w_up, ffn_w_down, router_w,
              moe_w_gate, moe_w_up, moe_w_down, ln_ffn_g, ln_ffn_b):
    for layer in range(DEPTH):
        m = hybrid_mixer(x, w_in[layer], conv_dw_w[layer], conv_dw_b[layer], conv_ln_g[layer],
                         conv_ln_b[layer], short_conv_w[layer], a_log[layer], dt_bias[layer],
                         out_norm_g[layer], w_out[layer])
        x = layer_norm(DEEPNORM_ALPHA * x + m, ln_mix_g[layer], ln_mix_b[layer])
        j = layer // 2
        if layer % 2 == 0:
            f = swiglu(x, ffn_w_gate[j], ffn_w_up[j], ffn_w_down[j])
        else:
            f = moe_swiglu(x, router_w[j], moe_w_gate[j], moe_w_up[j], moe_w_down[j])
        x = layer_norm(DEEPNORM_ALPHA * x + f, ln_ffn_g[layer], ln_ffn_b[layer])
    return x
```

```cpp
#include <hip/hip_runtime.h>
#include <cstdio>
#include <cstdint>

#ifndef MK_N_LAUNCHES
#define MK_N_LAUNCHES 1
#endif
#ifndef DN_NAIVE
#define DN_NAIVE 1
#endif

namespace pg8 {
#define PG8_LAS __attribute__((address_space(3)))
typedef unsigned short bf16_t;
typedef short bf16x8 __attribute__((ext_vector_type(8)));
typedef float f32x4 __attribute__((ext_vector_type(4)));
typedef unsigned u32x4 __attribute__((ext_vector_type(4)));
constexpr int BM = 256, BK = 64, HALF = 128, HTB = HALF * BK * 2  , STAGE_BYTES = 8 * HTB, NXCD = 8, WGM = 8;

__host__ __device__ __forceinline__ int lds_byte(int r, int c) { const int st = (r >> 4) * 2 + (c >> 5), rr = r & 15, cc = c & 31, ob = rr * 64 + cc * 2; return st * 1024 + (ob ^ (((ob >> 9) & 1) << 5)); }
__host__ __device__ __forceinline__ void stage_rc(int b, int& R, int& C) { const int st = b / 1024, sb = b % 1024, swz = sb ^ (((sb >> 9) & 1) << 5); R = (st >> 1) * 16 + swz / 64; C = (st & 1) * 32 + (swz % 64) / 2; }
__host__ __device__ __forceinline__ int perm32(int rho) { const int n = rho >> 4, i = rho & 15; return 8 * (i >> 2) + 4 * n + (i & 3); }

struct Unit { int pm, pn, om, on; };
struct Gemm { const bf16_t* A; const bf16_t* Bt; int M, N, K; };

struct StaticOrder {
    int nM, nN, nwg, G, c;
    __device__ __forceinline__ void init(int M, int N, int G_, int c_) { nM = M / BM; nN = N / BM; nwg = nM * nN; G = G_; c = c_; }
    __device__ __forceinline__ bool next(int i, Unit& u) const {
        const long L = (long)i * G + c; if (L >= nwg) return false;
        int wgid = (int)L; { const int q = nwg / NXCD, r = nwg % NXCD, xcd = wgid % NXCD, off = wgid / NXCD; wgid = (xcd < r ? xcd * (q + 1) : r * (q + 1) + (xcd - r) * q) + off; }
        const int nig = WGM * nN, gid = wgid / nig, fm = gid * WGM, gsz = (nM - fm) < WGM ? (nM - fm) : WGM;
        u.pm = fm + ((wgid % nig) % gsz); u.pn = (wgid % nig) / gsz; u.om = u.pm; u.on = u.pn; return true;
    }
    __device__ __forceinline__ void a_ready(const Unit&) const {}
    __device__ __forceinline__ void done(const Unit&) const {}
};
template <int MODE> struct MoeOrder {
    int nM, nN, nwg, G, c, t0; int tb1, tb2, tb3, tb4, tb5, tb6, tb7;
    __device__ __forceinline__ bool next(int i, Unit& u) const {
        const long L = (long)i * G + c; if (L >= nwg) return false;
        int wgid = (int)L; { const int q = nwg / NXCD, r = nwg % NXCD, xcd = wgid % NXCD, off = wgid / NXCD; wgid = (xcd < r ? xcd * (q + 1) : r * (q + 1) + (xcd - r) * q) + off; }
        const int nig = WGM * nN, gid = wgid / nig, fm = gid * WGM, gsz = (nM - fm) < WGM ? (nM - fm) : WGM;
        const int lm = fm + ((wgid % nig) % gsz), ln = (wgid % nig) / gsz, tile = t0 + lm;
        const int e = (tile >= tb1) + (tile >= tb2) + (tile >= tb3) + (tile >= tb4) + (tile >= tb5) + (tile >= tb6) + (tile >= tb7);
        u.pn = e * nN + ln; u.on = ln;
        if (MODE == 0) { u.pm = tile; u.om = lm; } else { u.pm = lm; u.om = tile; }
        return true;
    }
    __device__ __forceinline__ void a_ready(const Unit&) const {}
    __device__ __forceinline__ void done(const Unit&) const {}
};

__device__ __forceinline__ unsigned cvt_pk_bf16(float lo, float hi) { unsigned r; asm volatile("v_cvt_pk_bf16_f32 %0, %1, %2" : "=v"(r) : "v"(lo), "v"(hi)); return r; }
__device__ __forceinline__ float sigmoid_f(float x) { return __builtin_amdgcn_rcpf(1.0f + __expf(-x)); }
__device__ __forceinline__ float silu_f(float x) { return x * sigmoid_f(x); }

struct EpiInProj {
    static constexpr bool PERM = true, AFTER_DRAIN = false;
    bf16_t* GLU; bf16_t* QKV; bf16_t* Z;
    __device__ __forceinline__ void operator()(const f32x4 (&acc)[2][2][4][2], const Unit& u, int wr, int wc, int fr, int fq) const {
        const int row0 = u.om * BM + wr * 64 + fr, cl = wc * 32 + 8 * fq;
        if (u.on < 4) {
#pragma unroll
            for (int ai = 0; ai < 2; ++ai)
#pragma unroll
                for (int m = 0; m < 4; ++m) { bf16_t* rowp = GLU + (size_t)(row0 + ai * HALF + m * 16) * 512 + u.on * 128 + cl;
                    const f32x4 v0 = acc[ai][0][m][0], v1 = acc[ai][0][m][1], g0 = acc[ai][1][m][0], g1 = acc[ai][1][m][1];
                    u32x4 w; w.x = cvt_pk_bf16(v0[0] * sigmoid_f(g0[0]), v0[1] * sigmoid_f(g0[1])); w.y = cvt_pk_bf16(v0[2] * sigmoid_f(g0[2]), v0[3] * sigmoid_f(g0[3]));
                    w.z = cvt_pk_bf16(v1[0] * sigmoid_f(g1[0]), v1[1] * sigmoid_f(g1[1])); w.w = cvt_pk_bf16(v1[2] * sigmoid_f(g1[2]), v1[3] * sigmoid_f(g1[3]));
                    *(u32x4*)rowp = w; }
        } else if (u.on < 10) {
#pragma unroll
            for (int ai = 0; ai < 2; ++ai)
#pragma unroll
                for (int m = 0; m < 4; ++m) { bf16_t* rowp = QKV + (size_t)(row0 + ai * HALF + m * 16) * 1536 + (u.on - 4) * 256 + cl;
#pragma unroll
                    for (int bj = 0; bj < 2; ++bj) { const f32x4 v0 = acc[ai][bj][m][0], v1 = acc[ai][bj][m][1];
                        u32x4 w; w.x = cvt_pk_bf16(v0[0], v0[1]); w.y = cvt_pk_bf16(v0[2], v0[3]); w.z = cvt_pk_bf16(v1[0], v1[1]); w.w = cvt_pk_bf16(v1[2], v1[3]);
                        *(u32x4*)(rowp + bj * HALF) = w; } }
        } else {
#pragma unroll
            for (int ai = 0; ai < 2; ++ai)
#pragma unroll
                for (int m = 0; m < 4; ++m) { bf16_t* rowp = Z + (size_t)(row0 + ai * HALF + m * 16) * 512 + (u.on - 10) * 256 + cl;
#pragma unroll
                    for (int bj = 0; bj < 2; ++bj) { const f32x4 v0 = acc[ai][bj][m][0], v1 = acc[ai][bj][m][1];
                        u32x4 w; w.x = cvt_pk_bf16(silu_f(v0[0]), silu_f(v0[1])); w.y = cvt_pk_bf16(silu_f(v0[2]), silu_f(v0[3])); w.z = cvt_pk_bf16(silu_f(v1[0]), silu_f(v1[1])); w.w = cvt_pk_bf16(silu_f(v1[2]), silu_f(v1[3]));
                        *(u32x4*)(rowp + bj * HALF) = w; } }
        }
    }
};
struct EpiSwiGLU {
    static constexpr bool PERM = true, AFTER_DRAIN = false;
    bf16_t* H; int ldh;
    __device__ __forceinline__ void operator()(const f32x4 (&acc)[2][2][4][2], const Unit& u, int wr, int wc, int fr, int fq) const {
        const int row0 = u.om * BM + wr * 64 + fr, cl = u.on * 128 + wc * 32 + 8 * fq;
#pragma unroll
        for (int ai = 0; ai < 2; ++ai)
#pragma unroll
            for (int m = 0; m < 4; ++m) { bf16_t* rowp = H + (size_t)(row0 + ai * HALF + m * 16) * ldh + cl;
                const f32x4 g0 = acc[ai][0][m][0], g1 = acc[ai][0][m][1], u0 = acc[ai][1][m][0], u1 = acc[ai][1][m][1];
                u32x4 w; w.x = cvt_pk_bf16(silu_f(g0[0]) * u0[0], silu_f(g0[1]) * u0[1]); w.y = cvt_pk_bf16(silu_f(g0[2]) * u0[2], silu_f(g0[3]) * u0[3]);
                w.z = cvt_pk_bf16(silu_f(g1[0]) * u1[0], silu_f(g1[1]) * u1[1]); w.w = cvt_pk_bf16(silu_f(g1[2]) * u1[2], silu_f(g1[3]) * u1[3]);
                *(u32x4*)rowp = w; }
    }
};
struct EpiBf16 {
    static constexpr bool PERM = true, AFTER_DRAIN = false;
    bf16_t* O; int ldc;
    __device__ __forceinline__ void operator()(const f32x4 (&acc)[2][2][4][2], const Unit& u, int wr, int wc, int fr, int fq) const {
        const int row0 = u.om * BM + wr * 64 + fr, cl = u.on * BM + wc * 32 + 8 * fq;
#pragma unroll
        for (int ai = 0; ai < 2; ++ai)
#pragma unroll
            for (int m = 0; m < 4; ++m) { bf16_t* rowp = O + (size_t)(row0 + ai * HALF + m * 16) * ldc + cl;
#pragma unroll
                for (int bj = 0; bj < 2; ++bj) { const f32x4 v0 = acc[ai][bj][m][0], v1 = acc[ai][bj][m][1];
                    u32x4 w; w.x = cvt_pk_bf16(v0[0], v0[1]); w.y = cvt_pk_bf16(v0[2], v0[3]); w.z = cvt_pk_bf16(v1[0], v1[1]); w.w = cvt_pk_bf16(v1[2], v1[3]);
                    *(u32x4*)(rowp + bj * HALF) = w; } }
    }
};
struct EpiResid {
    static constexpr bool PERM = false, AFTER_DRAIN = false;
    const float* res; float* out; float alpha;
    __device__ __forceinline__ void operator()(const f32x4 (&acc)[2][2][4][2], const Unit& u, int wr, int wc, int fr, int fq) const {
        const int row0 = u.om * BM + wr * 64 + fr, col0 = u.on * BM + wc * 32 + 4 * fq;
#pragma unroll
        for (int ai = 0; ai < 2; ++ai)
#pragma unroll
            for (int m = 0; m < 4; ++m) { const size_t off = (size_t)(row0 + ai * HALF + m * 16) * 1024 + col0;
#pragma unroll
                for (int bj = 0; bj < 2; ++bj)
#pragma unroll
                    for (int n = 0; n < 2; ++n) { const f32x4 r = *(const f32x4*)(res + off + bj * HALF + n * 16); *(f32x4*)(out + off + bj * HALF + n * 16) = r * alpha + acc[ai][bj][m][n]; }
                asm volatile("" ::: "memory"); }
    }
};

template <class Epi, class Sched, bool ALIGN_EPI = false, bool SP2 = false>
__device__ __forceinline__ void gemm_phase(PG8_LAS unsigned char* lds, const Gemm g, const Sched& S, const Epi& E) {
    const int tid = threadIdx.x, wid = __builtin_amdgcn_readfirstlane(tid >> 6), lane = tid & 63, wr = wid >> 2, wc = wid & 3, fr = lane & 15, fq = lane >> 4;
    const int K = g.K, nt = K / BK;
    unsigned voffA[2], voffB[2];
#pragma unroll
    for (int i = 0; i < 2; ++i) { int R, C; stage_rc(tid * 16 + i * 8192, R, C); const int Rb = Epi::PERM ? ((R & ~31) + perm32(R & 31)) : R;
        voffA[i] = (unsigned)(R * K + C) * 2u; voffB[i] = (unsigned)(Rb * K + C) * 2u; }
    const size_t kstep = (size_t)(BK * 2);
    const size_t hstep = (size_t)HALF * K * 2;
    const size_t tstep = 2 * hstep;
    const unsigned ldsw = (unsigned)wid * 1024u;
    const int aoff = lds_byte(wr * 64 + fr, fq * 8), boff = lds_byte(wc * 32 + fr, fq * 8);
#define PG8_SA(b, h) (((b) * 2 + (h)) * HTB)
#define PG8_SB(b, h) ((4 + (b) * 2 + (h)) * HTB)
#define PG8_STAGE(bufoff, gbase, voff) do { _Pragma("unroll") for (int _i = 0; _i < 2; ++_i) \
        __builtin_amdgcn_global_load_lds((const unsigned*)((const char*)(gbase) + (voff)[_i]), (PG8_LAS unsigned*)(lds + (bufoff) + ldsw + _i * 8192), 16, 0, 0); } while (0)
#define PG8_LDA(dst, b, h) do { _Pragma("unroll") for (int m = 0; m < 4; ++m) _Pragma("unroll") for (int k = 0; k < 2; ++k) dst[m][k] = *(const PG8_LAS bf16x8*)(lds + PG8_SA(b, h) + aoff + m * 2048 + k * 1024); } while (0)
#define PG8_LDB(dst, b, h) do { _Pragma("unroll") for (int n = 0; n < 2; ++n) _Pragma("unroll") for (int k = 0; k < 2; ++k) dst[n][k] = *(const PG8_LAS bf16x8*)(lds + PG8_SB(b, h) + boff + n * 2048 + k * 1024); } while (0)
#define PG8_MMA(ai, bj, At, Bt) do { __builtin_amdgcn_s_setprio(1); _Pragma("unroll") for (int m = 0; m < 4; ++m) _Pragma("unroll") for (int n = 0; n < 2; ++n) _Pragma("unroll") for (int k = 0; k < 2; ++k) \
        acc[ai][bj][m][n] = __builtin_amdgcn_mfma_f32_16x16x32_bf16(Bt[n][k], At[m][k], acc[ai][bj][m][n], 0, 0, 0); __builtin_amdgcn_s_setprio(0); } while (0)
#define PG8_WAIT_V(n) asm volatile("s_waitcnt vmcnt(" #n ")" ::: "memory")
#define PG8_WAIT_L(n) asm volatile("s_waitcnt lgkmcnt(" #n ")" ::: "memory")
#define PG8_BAR __builtin_amdgcn_s_barrier()
#define PG8_SCHED __builtin_amdgcn_sched_barrier(0)
    Unit cur, nxt; int ui = 0;
    if (!S.next(0, cur)) return;
    f32x4 acc[2][2][4][2];
#pragma unroll
    for (int a = 0; a < 2; ++a)
#pragma unroll
        for (int b = 0; b < 2; ++b)
#pragma unroll
            for (int m = 0; m < 4; ++m)
#pragma unroll
                for (int n = 0; n < 2; ++n) acc[a][b][m][n] = (f32x4){0.f, 0.f, 0.f, 0.f};
    bf16x8 At[4][2], B0[2][2], B1[2][2];
    const char* cA = (const char*)g.A + (size_t)cur.pm * tstep; const char* cB = (const char*)g.Bt + (size_t)cur.pn * tstep;
    S.a_ready(cur);
    if constexpr (SP2) {
        PG8_STAGE(PG8_SB(0, 0), cB, voffB); PG8_STAGE(PG8_SB(0, 1), cB + hstep, voffB); PG8_STAGE(PG8_SA(0, 0), cA, voffA); PG8_STAGE(PG8_SA(0, 1), cA + hstep, voffA);
        if (wr == 1) PG8_BAR;
        PG8_WAIT_V(2); PG8_BAR;
        PG8_STAGE(PG8_SB(1, 0), cB + kstep, voffB); PG8_STAGE(PG8_SA(1, 0), cA + kstep, voffA); PG8_STAGE(PG8_SB(1, 1), cB + hstep + kstep, voffB);
        PG8_WAIT_V(6); PG8_BAR;
    } else {
        PG8_STAGE(PG8_SB(0, 0), cB, voffB); PG8_STAGE(PG8_SA(0, 0), cA, voffA); PG8_STAGE(PG8_SB(0, 1), cB + hstep, voffB); PG8_STAGE(PG8_SA(0, 1), cA + hstep, voffA);
        if (wr == 1) PG8_BAR;
        PG8_WAIT_V(4); PG8_BAR;
        PG8_STAGE(PG8_SB(1, 0), cB + kstep, voffB); PG8_STAGE(PG8_SA(1, 0), cA + kstep, voffA); PG8_STAGE(PG8_SB(1, 1), cB + hstep + kstep, voffB);
        PG8_WAIT_V(6); PG8_BAR;
    }
    for (;;) {
        const bool has_next = S.next(ui + 1, nxt);
        const char* nA = has_next ? (const char*)g.A + (size_t)nxt.pm * tstep : cA; const char* nB = has_next ? (const char*)g.Bt + (size_t)nxt.pn * tstep : cB;
        for (int t = 0; t < nt; t += 2) {
            const bool last = (t == nt - 2);
            const char* a1 = cA + (size_t)(t + 1) * kstep;
            const char* a2 = last ? nA : cA + (size_t)(t + 2) * kstep; const char* b2 = last ? nB : cB + (size_t)(t + 2) * kstep;
            const char* a3 = a2 + kstep; const char* b3 = b2 + kstep;
            if (last && has_next) S.a_ready(nxt);
            if constexpr (SP2) {
            PG8_LDB(B0, 0, 0); PG8_LDB(B1, 0, 1); PG8_SCHED; PG8_LDA(At, 0, 0); PG8_STAGE(PG8_SA(1, 1), a1 + hstep, voffA);
            PG8_WAIT_V(8); PG8_WAIT_L(0); PG8_BAR; PG8_MMA(0, 0, At, B0); PG8_MMA(0, 1, At, B1); PG8_BAR; PG8_SCHED;
            PG8_LDA(At, 0, 1); PG8_STAGE(PG8_SB(0, 0), b2, voffB); PG8_STAGE(PG8_SB(0, 1), b2 + hstep, voffB); PG8_STAGE(PG8_SA(0, 0), a2, voffA);
            PG8_WAIT_V(8); PG8_WAIT_L(0); PG8_BAR; PG8_MMA(1, 0, At, B0); PG8_MMA(1, 1, At, B1); PG8_BAR; PG8_SCHED;
            PG8_LDB(B0, 1, 0); PG8_LDB(B1, 1, 1); PG8_SCHED; PG8_LDA(At, 1, 0); PG8_STAGE(PG8_SA(0, 1), a2 + hstep, voffA);
            PG8_WAIT_V(8); PG8_WAIT_L(0); PG8_BAR; PG8_MMA(0, 0, At, B0); PG8_MMA(0, 1, At, B1); PG8_BAR; PG8_SCHED;
            PG8_LDA(At, 1, 1); PG8_STAGE(PG8_SB(1, 0), b3, voffB); PG8_STAGE(PG8_SB(1, 1), b3 + hstep, voffB); PG8_STAGE(PG8_SA(1, 0), a3, voffA);
            PG8_WAIT_V(8); PG8_WAIT_L(0); PG8_BAR; PG8_MMA(1, 0, At, B0); PG8_MMA(1, 1, At, B1); PG8_BAR; PG8_SCHED;
            } else {
            PG8_LDB(B0, 0, 0); PG8_SCHED; PG8_LDA(At, 0, 0); PG8_STAGE(PG8_SA(1, 1), a1 + hstep, voffA);
            PG8_WAIT_L(8); PG8_BAR; PG8_WAIT_L(0); PG8_MMA(0, 0, At, B0); PG8_BAR; PG8_SCHED;
            PG8_LDB(B1, 0, 1); PG8_STAGE(PG8_SB(0, 0), b2, voffB);
            PG8_BAR; PG8_WAIT_L(0); PG8_MMA(0, 1, At, B1); PG8_BAR;
            PG8_LDA(At, 0, 1); PG8_STAGE(PG8_SA(0, 0), a2, voffA);
            PG8_BAR; PG8_WAIT_L(0); PG8_MMA(1, 0, At, B0); PG8_BAR; PG8_SCHED;
            PG8_STAGE(PG8_SB(0, 1), b2 + hstep, voffB);
            PG8_WAIT_V(6); PG8_BAR; PG8_MMA(1, 1, At, B1); PG8_BAR;
            PG8_LDB(B0, 1, 0); PG8_SCHED; PG8_LDA(At, 1, 0); PG8_STAGE(PG8_SA(0, 1), a2 + hstep, voffA);
            PG8_WAIT_L(8); PG8_BAR; PG8_WAIT_L(0); PG8_MMA(0, 0, At, B0); PG8_BAR; PG8_SCHED;
            PG8_LDB(B1, 1, 1); PG8_STAGE(PG8_SB(1, 0), b3, voffB);
            PG8_BAR; PG8_WAIT_L(0); PG8_MMA(0, 1, At, B1); PG8_BAR;
            PG8_LDA(At, 1, 1); PG8_STAGE(PG8_SA(1, 0), a3, voffA);
            PG8_BAR; PG8_WAIT_L(0); PG8_MMA(1, 0, At, B0); PG8_BAR; PG8_SCHED;
            PG8_STAGE(PG8_SB(1, 1), b3 + hstep, voffB);
            PG8_WAIT_V(6); PG8_BAR; PG8_MMA(1, 1, At, B1); PG8_BAR;
            }
        }
        if constexpr (ALIGN_EPI) { if (wr == 0) PG8_BAR; }
        if constexpr (!Epi::AFTER_DRAIN) { E(acc, cur, wr, wc, fr, fq); S.done(cur); }
        if (!has_next) break;
#pragma unroll
        for (int a = 0; a < 2; ++a)
#pragma unroll
            for (int b = 0; b < 2; ++b)
#pragma unroll
                for (int m = 0; m < 4; ++m)
#pragma unroll
                    for (int n = 0; n < 2; ++n) acc[a][b][m][n] = (f32x4){0.f, 0.f, 0.f, 0.f};
        cur = nxt; cA = nA; cB = nB; ++ui;
        if constexpr (ALIGN_EPI) { if (wr == 1) PG8_BAR; }
    }
    PG8_WAIT_V(0);
    if constexpr (!ALIGN_EPI) { if (wr == 0) PG8_BAR; }
    PG8_BAR;
    if constexpr (Epi::AFTER_DRAIN) { E.fused(acc, cur, wr, wc, fr, fq, lds, wid, lane); S.done(cur); }
#undef PG8_SA
#undef PG8_SB
#undef PG8_STAGE
#undef PG8_LDA
#undef PG8_LDB
#undef PG8_MMA
#undef PG8_WAIT_V
#undef PG8_WAIT_L
#undef PG8_BAR
#undef PG8_SCHED
}
}

constexpr int NWAVES = 8;
constexpr int BATCH = 2, SEQ = 16384, D = 1024, M = BATCH * SEQ;
constexpr int NIN = 3072, IN_COLS = 3080, FF0 = 2816, NE = 8, FFE = 3584;
constexpr float LN_EPS = 1e-5f;
constexpr float ALPHA = 1.41421356237309515f;
constexpr int NPH = 32;
constexpr size_t MiB = 1u << 20;
constexpr size_t WS_CTL = 0, CTL_ZERO_BYTES = 1 * MiB;
constexpr size_t WS_WGT = 1 * MiB;
constexpr size_t WS_COUNTS = 1 * MiB + 65536;
constexpr size_t WS_META = WS_COUNTS + 8192;
constexpr size_t WS_G8 = 2 * MiB;
constexpr size_t WS_GB = 3 * MiB;
constexpr size_t WS_GG = 3 * MiB + 512 * 1024;
constexpr size_t WS_RI = 4 * MiB;
constexpr size_t WS_RG = 4 * MiB + 512 * 1024;
constexpr size_t WS_POS = 4 * MiB + 768 * 1024;
constexpr size_t WS_WIN = 6 * MiB;
constexpr size_t WS_WOUT = 18 * MiB;
constexpr size_t WS_WGU0 = 22 * MiB;
constexpr size_t WS_WD0 = 33 * MiB;
constexpr size_t WS_XB = 40 * MiB;
constexpr size_t WS_OL = 40 * MiB;
constexpr size_t WS_QT = 72 * MiB;
constexpr size_t WS_R = 104 * MiB;
constexpr size_t WS_GLU = WS_R, WS_QKV = WS_R + 32 * MiB, WS_Z = WS_R + 128 * MiB, WS_YCAT = WS_R + 160 * MiB, WS_QKVN = WS_R + 224 * MiB;
constexpr size_t WS_HID0 = WS_R;
constexpr size_t WS_WMGU = WS_R, WS_WMD = WS_R + 112 * MiB, WS_XG = WS_R + 168 * MiB, WS_HIDM = WS_R + 300 * MiB, WS_END = WS_R + 412 * MiB;
constexpr int XG_ROWS = 2 * M + NE * 256;
static_assert(WS_XG + (size_t)XG_ROWS * D * 2 <= WS_HIDM && WS_HIDM + (size_t)16384 * FFE * 2 <= WS_END, "ws map");
constexpr int CW_BAR = 4096;
constexpr int RING_BYTES = 131072, LDSCTL_OFF = RING_BYTES, MISC_OFF = LDSCTL_OFF + 320, LDS_BYTES = 147456;

#define LAS __attribute__((address_space(3)))
typedef unsigned short bf16;
typedef unsigned v4u __attribute__((ext_vector_type(4)));
typedef unsigned v2u __attribute__((ext_vector_type(2)));
typedef float f32x4 __attribute__((ext_vector_type(4)));
typedef float f32x2 __attribute__((ext_vector_type(2)));
typedef short bf16x8 __attribute__((ext_vector_type(8)));
#define LDS_WAIT() asm volatile("s_waitcnt lgkmcnt(0)" ::: "memory")
__device__ __forceinline__ unsigned f2bf(float f) { unsigned u = __builtin_bit_cast(unsigned, f); return (u + 0x7fffu + ((u >> 16) & 1u)) >> 16; }
__device__ __forceinline__ unsigned pk2(float lo, float hi) { return f2bf(lo) | (f2bf(hi) << 16); }
__device__ __forceinline__ float bflo(unsigned u) { return __builtin_bit_cast(float, u << 16); }
__device__ __forceinline__ float bfhi(unsigned u) { return __builtin_bit_cast(float, u & 0xffff0000u); }
__device__ __forceinline__ float wave_sum(float v) {
#pragma unroll
    for (int o = 1; o < 64; o <<= 1) v += __shfl_xor(v, o);
    return v;
}
__device__ __forceinline__ float sigm(float x) { return 1.0f / (1.0f + __expf(-x)); }

#define XB_TMO      128
#define XB_XCNT(j)  (256  + 64 * (j))
#define XB_XSUB(j)  (1280 + 64 * (j))
#define XB_XGEN(j)  (2304 + 64 * (j))
#define XB_TOP      3328
#define XB_TOPGEN   3392
#define XCD_BAR_WORDS 3456
#define XB_SPIN_CAP (1u << 18)
__device__ __forceinline__ unsigned xb_ld(unsigned* p)              { return __hip_atomic_load(p, __ATOMIC_RELAXED, __HIP_MEMORY_SCOPE_AGENT); }
__device__ __forceinline__ unsigned xb_add(unsigned* p, unsigned v) { return __hip_atomic_fetch_add(p, v, __ATOMIC_RELAXED, __HIP_MEMORY_SCOPE_AGENT); }
__device__ __forceinline__ unsigned xb_xcc_id() { return (unsigned)__builtin_amdgcn_s_getreg((3 << 11) | 20) & 0xFu; }
#define XB_SPIN(cond, bar) do { unsigned _sp = 0; while (cond) { __builtin_amdgcn_s_sleep(1); \
    if ((++_sp & 255u) == 0u) { if (xb_ld(&(bar)[XB_TMO])) break; if (_sp > XB_SPIN_CAP) { atomicAdd(&(bar)[XB_TMO], 1u); break; } } } } while (0)
struct XcdBarrier { unsigned* bar; unsigned x; volatile LAS unsigned* st; };
__device__ __forceinline__ XcdBarrier xcd_barrier_post(unsigned* bar, volatile LAS unsigned* st) {
    XcdBarrier b; b.bar = bar; b.x = xb_xcc_id(); b.st = st;
    if (threadIdx.x == 0) (void)xb_add(&bar[XB_XCNT(b.x)], 1u);
    return b;
}
__device__ __forceinline__ void xcd_barrier_complete(unsigned* bar, unsigned x, unsigned& nloc, unsigned& nx) {
    const unsigned G = gridDim.x * gridDim.y * gridDim.z;
    unsigned sum, cnt, mine, sp = 0u;
    for (;;) {
        sum = 0u; cnt = 0u; mine = 0u;
#pragma unroll
        for (unsigned j = 0; j < 16; ++j) { const unsigned c = xb_ld(&bar[XB_XCNT(j)]); sum += c; cnt += (c > 0u) ? 1u : 0u; mine = (j == x) ? c : mine; }
        if (sum == G) break;
        __builtin_amdgcn_s_sleep(1);
        if ((++sp & 255u) == 0u) { if (xb_ld(&bar[XB_TMO])) break; if (sp > XB_SPIN_CAP) { atomicAdd(&bar[XB_TMO], 1u); break; } }
    }
    nloc = mine > 0u ? mine : 1u; nx = cnt > 0u ? cnt : 1u;
}
__device__ __forceinline__ void xcd_barrier(const XcdBarrier& b) {
    asm volatile("s_waitcnt vmcnt(0)" ::: "memory");
    __syncthreads();
    if (threadIdx.x == 0) {
        unsigned* bar = b.bar;
        __builtin_amdgcn_s_waitcnt(0);
        unsigned nloc = b.st[0], nx = b.st[1];
        if (nloc == 0u) { xcd_barrier_complete(bar, b.x, nloc, nx); b.st[0] = nloc; b.st[1] = nx; }
        const unsigned old = xb_add(&bar[XB_XSUB(b.x)], 1u);
        const unsigned gen = old / nloc;
        if (old + 1u == (gen + 1u) * nloc) {
            __builtin_amdgcn_fence(__ATOMIC_RELEASE, "agent");
            asm volatile("s_waitcnt vmcnt(0)" ::: "memory");
            const unsigned og = xb_add(&bar[XB_TOP], 1u);
            const unsigned tg = og / nx;
            if (og + 1u == (tg + 1u) * nx) xb_add(&bar[XB_TOPGEN], 1u);
            else XB_SPIN(xb_ld(&bar[XB_TOPGEN]) == tg, bar);
            __builtin_amdgcn_fence(__ATOMIC_ACQUIRE, "agent");
            xb_add(&bar[XB_XGEN(b.x)], 1u);
            asm volatile("s_waitcnt vmcnt(0)" ::: "memory");
        } else {
            XB_SPIN(xb_ld(&bar[XB_XGEN(b.x)]) == gen, bar);
            __builtin_amdgcn_fence(__ATOMIC_ACQUIRE, "agent");
            asm volatile("s_waitcnt vmcnt(0)" ::: "memory");
        }
    }
    __syncthreads();
}

__device__ __forceinline__ void transpose_item(const float* W, int ldw, bf16* WT, int Kd, int k0, int n0, int drow0, LAS float* scr, int lane) {
#pragma unroll 8
    for (int i = 0; i < 32; ++i) { const int kk = 2 * i + (lane >> 5); scr[kk * 33 + (lane & 31)] = W[(size_t)(k0 + kk) * ldw + n0 + (lane & 31)]; }
    LDS_WAIT();
    const int c = lane & 7;
#pragma unroll
    for (int j = 0; j < 4; ++j) { const int n = (lane >> 3) + 8 * j; const LAS float* s = scr + (8 * c) * 33 + n;
        v4u o; o.x = pk2(s[0 * 33], s[1 * 33]); o.y = pk2(s[2 * 33], s[3 * 33]); o.z = pk2(s[4 * 33], s[5 * 33]); o.w = pk2(s[6 * 33], s[7 * 33]);
        *(v4u*)(WT + (size_t)(drow0 + n) * Kd + k0 + 8 * c) = o; }
    LDS_WAIT();
}
__device__ __forceinline__ void convert_ffn_item(const float* Wg, const float* Wu, const float* Wd, int F, bf16* WGU, bf16* WD, int r, LAS float* scr, int lane) {
    const int per = 16 * (F / 32);
    const int which = r / per, blk = r % per;
    if (which < 2) { const int nblk = F / 32, kb = blk / nblk, nb = blk % nblk, n0 = 32 * nb;
        transpose_item(which ? Wu : Wg, F, WGU, 1024, 64 * kb, n0, 256 * (n0 >> 7) + (n0 & 127) + (which ? 128 : 0), scr, lane); }
    else { const int kb = blk / 32, nb = blk % 32; transpose_item(Wd, 1024, WD, F, 64 * kb, 32 * nb, 32 * nb, scr, lane); }
}

__device__ __forceinline__ void prologue_phase(const float* x, const float* w_in, const float* w_out, const float* fg, const float* fu, const float* fd, unsigned char* ws, LAS unsigned char* lds, int gw, int NGW, int wave, int lane) {
    LAS float* scr = (LAS float*)(lds + wave * 16384);
    for (int it = gw; it < 2 * 16 * 96; it += NGW) { const int l = it / 1536, r = it % 1536, kb = r / 96, nb = r % 96, n0 = 32 * nb;
        const int drow0 = n0 < 512 ? 256 * (n0 >> 7) + (n0 & 127) : (n0 < 1024 ? 256 * ((n0 - 512) >> 7) + 128 + (n0 & 127) : n0);
        transpose_item(w_in + (size_t)l * 1024 * IN_COLS, IN_COLS, (bf16*)(ws + WS_WIN) + (size_t)l * NIN * 1024, 1024, 64 * kb, n0, drow0, scr, lane); }
    for (int it = gw; it < 2 * 16 * 32; it += NGW) { const int l = it / 512, r = it % 512, kb = r / 32, nb = r % 32;
        transpose_item(w_out + (size_t)l * 1024 * 1024, 1024, (bf16*)(ws + WS_WOUT) + (size_t)l * 1024 * 1024, 1024, 64 * kb, 32 * nb, 32 * nb, scr, lane); }
    for (int it = gw; it < 3 * 16 * (FF0 / 32); it += NGW) convert_ffn_item(fg, fu, fd, FF0, (bf16*)(ws + WS_WGU0), (bf16*)(ws + WS_WD0), it, scr, lane);
    { bf16* WGT = (bf16*)(ws + WS_WGT); const int tid = gw * 64 + lane, nth = NGW * 64;
      for (int i = tid; i < 2 * 16 * 1024; i += nth) { const int l = i >> 14, j = (i >> 10) & 15, k = i & 1023; WGT[i] = (bf16)(j < 8 ? f2bf(w_in[(size_t)l * 1024 * IN_COLS + (size_t)k * IN_COLS + NIN + j]) : 0u); } }
    { const f32x4* xs = (const f32x4*)x; v4u* xb = (v4u*)(ws + WS_XB); const size_t tid = (size_t)gw * 64 + lane, nth = (size_t)NGW * 64;
      for (size_t i = tid; i < (size_t)M * D / 8; i += nth) { const f32x4 a = xs[2 * i], b = xs[2 * i + 1]; v4u o; o.x = pk2(a.x, a.y); o.y = pk2(a.z, a.w); o.z = pk2(b.x, b.y); o.w = pk2(b.z, b.w); xb[i] = o; } }
}
__device__ __forceinline__ void moe_convert_phase(const float* mg, const float* mu, const float* md, unsigned char* ws, LAS unsigned char* lds, int gw, int NGW, int wave, int lane) {
    LAS float* scr = (LAS float*)(lds + wave * 16384);
    constexpr int PER_E = 3 * 16 * (FFE / 32);
    for (int it = gw; it < NE * PER_E; it += NGW) { const int e = it / PER_E, r = it % PER_E;
        convert_ffn_item(mg + (size_t)e * 1024 * FFE, mu + (size_t)e * 1024 * FFE, md + (size_t)e * FFE * 1024, FFE, (bf16*)(ws + WS_WMGU) + (size_t)e * 2 * FFE * 1024, (bf16*)(ws + WS_WMD) + (size_t)e * 1024 * FFE, r, scr, lane); }
}
__device__ __forceinline__ void gates_phase(const bf16* XB, const bf16* WgT, float* G8, int gw, int NGW, int lane) {
    for (int tg = gw; tg < M / 16; tg += NGW) {
        const int t0 = tg * 16; f32x4 acc = {0.f, 0.f, 0.f, 0.f};
        const bf16* ap = XB + (size_t)(t0 + (lane & 15)) * D + 8 * (lane >> 4);
        const bf16* bp = WgT + (size_t)(lane & 15) * D + 8 * (lane >> 4);
#pragma unroll 8
        for (int s = 0; s < 32; ++s) { const bf16x8 a = *(const bf16x8*)(ap + 32 * s), b = *(const bf16x8*)(bp + 32 * s); acc = __builtin_amdgcn_mfma_f32_16x16x32_bf16(a, b, acc, 0, 0, 0); }
        if ((lane & 15) < 8) {
#pragma unroll
            for (int i = 0; i < 4; ++i) G8[(size_t)(t0 + 4 * (lane >> 4) + i) * 8 + (lane & 15)] = acc[i]; }
    }
}
__device__ __forceinline__ void conv_phase(const bf16* GLU, bf16* YCAT, const float* dw_w, const float* dw_b, const float* lg, const float* lb, LAS unsigned char* lds, int item0, int istride, int wave, int lane) {
    const int cg = wave & 3, th = wave >> 2, c0 = cg * 128 + 2 * lane;
    float w0[31], w1[31];
#pragma unroll
    for (int j = 0; j < 31; ++j) { const f32x2 w = *(const f32x2*)(dw_w + j * 512 + c0); w0[j] = w.x; w1[j] = w.y; }
    const f32x2 bias = *(const f32x2*)(dw_b + c0), gam = *(const f32x2*)(lg + c0), bet = *(const f32x2*)(lb + c0);
    LAS f32x2* part = (LAS f32x2*)lds;
    int buf = 0;
    for (int item = item0; item < M / 64; item += istride) {
        const int b = item >> 8, n = item & 255;
        for (int tb = 0; tb < 4; ++tb) {
            const int tl = n * 64 + th * 32 + tb * 8;
            unsigned in[38];
#pragma unroll
            for (int r = 0; r < 38; ++r) { const int t = tl - 30 + r; const unsigned v = *(const unsigned*)(GLU + (size_t)(b * SEQ + (t < 0 ? 0 : t)) * 512 + c0); in[r] = (t >= 0) ? v : 0u; }
            float a0[8], a1[8];
#pragma unroll
            for (int i = 0; i < 8; ++i) { a0[i] = bias.x; a1[i] = bias.y; }
#pragma unroll
            for (int r = 0; r < 38; ++r) { const float x0 = bflo(in[r]), x1 = bfhi(in[r]);
#pragma unroll
                for (int i = 0; i < 8; ++i) { const int j = r - i; if (j >= 0 && j <= 30) { a0[i] += w0[j] * x0; a1[i] += w1[j] * x1; } } }
#pragma unroll
            for (int i = 0; i < 8; ++i) { const float s = wave_sum(a0[i] + a1[i]), q = wave_sum(a0[i] * a0[i] + a1[i] * a1[i]);
                if (lane == 0) part[((buf * 2 + th) * 8 + i) * 4 + cg] = (f32x2){s, q}; }
            __syncthreads();
#pragma unroll
            for (int i = 0; i < 8; ++i) { const LAS f32x2* pp = part + ((buf * 2 + th) * 8 + i) * 4; const f32x2 p0 = pp[0], p1 = pp[1], p2 = pp[2], p3 = pp[3];
                const float mean = ((p0.x + p1.x) + (p2.x + p3.x)) * (1.f / 512.f), ex2 = ((p0.y + p1.y) + (p2.y + p3.y)) * (1.f / 512.f);
                const float rstd = rsqrtf(fmaxf(ex2 - mean * mean, 0.f) + LN_EPS);
                const float y0 = (a0[i] - mean) * rstd * gam.x + bet.x, y1 = (a1[i] - mean) * rstd * gam.y + bet.y;
                *(unsigned*)(YCAT + (size_t)(b * SEQ + tl + i) * D + c0) = pk2(y0 * sigm(y0), y1 * sigm(y1)); }
            buf ^= 1;
        }
    }
}
__device__ __forceinline__ void dnpre_phase(const bf16* QKV, bf16* QKVN, const float* G8, float* GB, float* GG, const float* scw, const float* a_log, const float* dt_bias, int gw, int NGW, int lane) {
    for (int it = gw; it < (M / 16) * 4; it += NGW) {
        const int h = it & 3, row0 = (it >> 2) * 16, tl0 = row0 & (SEQ - 1), ch = h * 128 + 2 * lane;
        f32x2 wq[4], wk[4], wv[4];
#pragma unroll
        for (int j = 0; j < 4; ++j) { wq[j] = *(const f32x2*)(scw + j * 1536 + ch); wk[j] = *(const f32x2*)(scw + j * 1536 + 512 + ch); wv[j] = *(const f32x2*)(scw + j * 1536 + 1024 + ch); }
        const float nA = -__expf(a_log[h]), dtb = dt_bias[h];
        for (int i = 0; i < 16; ++i) {
            const int row = row0 + i, tl = tl0 + i;
            float q0 = 0.f, q1 = 0.f, k0 = 0.f, k1 = 0.f, v0 = 0.f, v1 = 0.f;
#pragma unroll
            for (int j = 0; j < 4; ++j) { if (tl - 3 + j >= 0) { const bf16* p = QKV + (size_t)(row - 3 + j) * 1536 + ch;
                const unsigned uq = *(const unsigned*)p, uk = *(const unsigned*)(p + 512), uv = *(const unsigned*)(p + 1024);
                q0 += wq[j].x * bflo(uq); q1 += wq[j].y * bfhi(uq); k0 += wk[j].x * bflo(uk); k1 += wk[j].y * bfhi(uk); v0 += wv[j].x * bflo(uv); v1 += wv[j].y * bfhi(uv); } }
            q0 *= sigm(q0); q1 *= sigm(q1); k0 *= sigm(k0); k1 *= sigm(k1); v0 *= sigm(v0); v1 *= sigm(v1);
            const float sq = wave_sum(q0 * q0 + q1 * q1), sk = wave_sum(k0 * k0 + k1 * k1);
            const float rq = rsqrtf(sq + 1e-6f) * 0.08838834764831845f, rk = rsqrtf(sk + 1e-6f);
            bf16* o = QKVN + (size_t)row * 1536 + ch;
            *(unsigned*)o = pk2(q0 * rq, q1 * rq); *(unsigned*)(o + 512) = pk2(k0 * rk, k1 * rk); *(unsigned*)(o + 1024) = pk2(v0, v1);
            if (lane == 0) { const float bl = G8[(size_t)row * 8 + h], al = G8[(size_t)row * 8 + 4 + h] + dtb;
                const float sp = al > 15.f ? al : log1pf(__expf(al));
                GB[(size_t)row * 4 + h] = sigm(bl); GG[(size_t)row * 4 + h] = nA * sp; }
        }
    }
}
#if DN_NAIVE
__device__ __forceinline__ void dn_naive_phase(const bf16* QKVN, const float* GB, const float* GG, bf16* OL, int worker, int lane) {
    const int b = worker >> 7, h = (worker >> 5) & 3, eg = worker & 31;
    float S0[4] = {0.f, 0.f, 0.f, 0.f}, S1[4] = {0.f, 0.f, 0.f, 0.f};
    for (int t0 = 0; t0 < SEQ; t0 += 8) {
        unsigned kk[8], qq[8]; v2u vv[8]; float be[8], al[8];
#pragma unroll
        for (int i = 0; i < 8; ++i) { const size_t row = (size_t)b * SEQ + t0 + i; const bf16* p = QKVN + row * 1536 + h * 128;
            qq[i] = *(const unsigned*)(p + 2 * lane); kk[i] = *(const unsigned*)(p + 512 + 2 * lane); vv[i] = *(const v2u*)(p + 1024 + 4 * eg);
            be[i] = GB[row * 4 + h]; al[i] = GG[row * 4 + h]; }
#pragma unroll
        for (int i = 0; i < 8; ++i) {
            const float a = __expf(al[i]), k0 = bflo(kk[i]), k1 = bfhi(kk[i]), q0 = bflo(qq[i]), q1 = bfhi(qq[i]);
            const float v[4] = {bflo(vv[i].x), bfhi(vv[i].x), bflo(vv[i].y), bfhi(vv[i].y)};
            float ks[4], o[4];
#pragma unroll
            for (int e = 0; e < 4; ++e) { S0[e] *= a; S1[e] *= a; ks[e] = k0 * S0[e] + k1 * S1[e]; }
#pragma unroll
            for (int e = 0; e < 4; ++e) ks[e] = wave_sum(ks[e]);
#pragma unroll
            for (int e = 0; e < 4; ++e) { const float d = be[i] * (v[e] - ks[e]); S0[e] += k0 * d; S1[e] += k1 * d; o[e] = q0 * S0[e] + q1 * S1[e]; }
#pragma unroll
            for (int e = 0; e < 4; ++e) o[e] = wave_sum(o[e]);
            if (lane == 0) { v2u w; w.x = pk2(o[0], o[1]); w.y = pk2(o[2], o[3]); *(v2u*)(OL + ((size_t)b * SEQ + t0 + i) * 512 + h * 128 + 4 * eg) = w; }
        }
    }
}
#endif
__device__ __forceinline__ void dnnorm_phase(const bf16* OL, const bf16* Z, const float* on_g, bf16* YCAT, int gw, int NGW, int lane) {
    const f32x4 g0 = *(const f32x4*)(on_g + (8 * lane & 127)), g1 = *(const f32x4*)(on_g + (8 * lane & 127) + 4);
    for (int m = gw; m < M; m += NGW) {
        const v4u uo = *(const v4u*)(OL + (size_t)m * 512 + 8 * lane), uz = *(const v4u*)(Z + (size_t)m * 512 + 8 * lane);
        float o[8] = {bflo(uo.x), bfhi(uo.x), bflo(uo.y), bfhi(uo.y), bflo(uo.z), bfhi(uo.z), bflo(uo.w), bfhi(uo.w)};
        const float z[8] = {bflo(uz.x), bfhi(uz.x), bflo(uz.y), bfhi(uz.y), bflo(uz.z), bfhi(uz.z), bflo(uz.w), bfhi(uz.w)};
        float s = 0.f;
#pragma unroll
        for (int i = 0; i < 8; ++i) s += o[i] * o[i];
        s += __shfl_xor(s, 1); s += __shfl_xor(s, 2); s += __shfl_xor(s, 4); s += __shfl_xor(s, 8);
        const float r = rsqrtf(s * (1.f / 128.f) + 1e-6f);
        v4u w; w.x = pk2(o[0] * r * g0.x * z[0], o[1] * r * g0.y * z[1]); w.y = pk2(o[2] * r * g0.z * z[2], o[3] * r * g0.w * z[3]);
        w.z = pk2(o[4] * r * g1.x * z[4], o[5] * r * g1.y * z[5]); w.w = pk2(o[6] * r * g1.z * z[6], o[7] * r * g1.w * z[7]);
        *(v4u*)(YCAT + (size_t)m * D + 512 + 8 * lane) = w;
    }
}
__device__ __forceinline__ void ln_row(float* xrow, bf16* brow, const f32x4 (&gv)[4], const f32x4 (&bv)[4], int lane, f32x4 (&o)[4]) {
    f32x4* xr = (f32x4*)xrow + lane; f32x4 v[4]; float s = 0.f;
#pragma unroll
    for (int j = 0; j < 4; ++j) { v[j] = xr[64 * j]; s += (v[j].x + v[j].y) + (v[j].z + v[j].w); }
    const float mean = wave_sum(s) * (1.f / D); float s2 = 0.f;
#pragma unroll
    for (int j = 0; j < 4; ++j) { v[j] = v[j] - mean; s2 += (v[j].x * v[j].x + v[j].y * v[j].y) + (v[j].z * v[j].z + v[j].w * v[j].w); }
    const float rstd = rsqrtf(wave_sum(s2) * (1.f / D) + LN_EPS);
    v2u* o8 = (v2u*)brow + lane;
#pragma unroll
    for (int j = 0; j < 4; ++j) { o[j] = v[j] * rstd * gv[j] + bv[j]; xr[64 * j] = o[j]; v2u w; w.x = pk2(o[j].x, o[j].y); w.y = pk2(o[j].z, o[j].w); o8[64 * j] = w; }
}
__device__ __forceinline__ void ln_phase(float* X, bf16* XB, const float* g, const float* b, int gw, int NGW, int lane) {
    f32x4 gv[4], bv[4], o[4];
#pragma unroll
    for (int j = 0; j < 4; ++j) { gv[j] = ((const f32x4*)g)[lane + 64 * j]; bv[j] = ((const f32x4*)b)[lane + 64 * j]; }
    for (int m = gw; m < M; m += NGW) ln_row(X + (size_t)m * D, XB + (size_t)m * D, gv, bv, lane, o);
}
__device__ __forceinline__ void ln_router_phase(float* X, bf16* XB, const float* g, const float* b, const float* Wr, int4* RI, f32x2* RG, int* COUNTS, LAS unsigned char* lds, int wg, int tid, int wave, int lane) {
    LAS float* wl = (LAS float*)lds;
    LAS int* wcnt = (LAS int*)(lds + 32768);
    for (int i = tid; i < 2048; i += 512) ((LAS f32x4*)wl)[i] = ((const f32x4*)Wr)[i];
    __syncthreads();
    f32x4 gv[4], bv[4], o[4];
#pragma unroll
    for (int j = 0; j < 4; ++j) { gv[j] = ((const f32x4*)g)[lane + 64 * j]; bv[j] = ((const f32x4*)b)[lane + 64 * j]; }
    int c0 = 0, c1 = 0, c2 = 0, c3 = 0, c4 = 0, c5 = 0, c6 = 0, c7 = 0;
    int se1 = 0, se2 = 0, sr1 = 0, sr2 = 0; float sg1 = 0.f, sg2 = 0.f;
    const int rowb = wg * 128 + wave * 16;
    for (int i = 0; i < 16; ++i) {
        const int row = rowb + i;
        ln_row(X + (size_t)row * D, XB + (size_t)row * D, gv, bv, lane, o);
        float lgt[8] = {0.f, 0.f, 0.f, 0.f, 0.f, 0.f, 0.f, 0.f};
#pragma unroll
        for (int j = 0; j < 4; ++j)
#pragma unroll
            for (int c = 0; c < 4; ++c) { const int k = 256 * j + 4 * lane + c; const f32x4 wa = *(const LAS f32x4*)(wl + k * 8), wb = *(const LAS f32x4*)(wl + k * 8 + 4); const float xv = o[j][c];
                lgt[0] += xv * wa.x; lgt[1] += xv * wa.y; lgt[2] += xv * wa.z; lgt[3] += xv * wa.w; lgt[4] += xv * wb.x; lgt[5] += xv * wb.y; lgt[6] += xv * wb.z; lgt[7] += xv * wb.w; }
#pragma unroll
        for (int e = 0; e < 8; ++e) lgt[e] = wave_sum(lgt[e]);
        int i1 = 0; float v1 = lgt[0];
#pragma unroll
        for (int e = 1; e < 8; ++e) if (lgt[e] > v1) { v1 = lgt[e]; i1 = e; }
        int i2 = -1; float v2 = -3.0e38f;
#pragma unroll
        for (int e = 0; e < 8; ++e) if (e != i1 && lgt[e] > v2) { v2 = lgt[e]; i2 = e; }
        const float g1 = 1.0f / (1.0f + __expf(v2 - v1)), g2 = 1.0f - g1;
        int r1 = 0, r2 = 0;
#define RCNT(e, c) { r1 = (i1 == e) ? c : r1; r2 = (i2 == e) ? c : r2; c += (i1 == e) + (i2 == e); }
        RCNT(0, c0) RCNT(1, c1) RCNT(2, c2) RCNT(3, c3) RCNT(4, c4) RCNT(5, c5) RCNT(6, c6) RCNT(7, c7)
#undef RCNT
        if (lane == i) { se1 = i1; se2 = i2; sr1 = r1; sr2 = r2; sg1 = g1; sg2 = g2; }
    }
    if (lane < 8) { const int cv = lane == 0 ? c0 : lane == 1 ? c1 : lane == 2 ? c2 : lane == 3 ? c3 : lane == 4 ? c4 : lane == 5 ? c5 : lane == 6 ? c6 : c7; wcnt[wave * 8 + lane] = cv; }
    __syncthreads();
    if (lane < 16) { int o1 = 0, o2 = 0;
        for (int w = 0; w < wave; ++w) { o1 += wcnt[w * 8 + se1]; o2 += wcnt[w * 8 + se2]; }
        RI[rowb + lane] = make_int4(se1, se2, sr1 + o1, sr2 + o2); RG[rowb + lane] = (f32x2){sg1, sg2}; }
    if (tid < 8) { int s = 0;
#pragma unroll
        for (int w = 0; w < 8; ++w) s += wcnt[w * 8 + tid];
        COUNTS[wg * 8 + tid] = s; }
    __syncthreads();
}
__device__ __forceinline__ void moe_gather_phase(const bf16* XB, bf16* XG, const int4* RI, int2* POS, const int* COUNTS, int* META, LAS unsigned char* lds, int wg, int tid, int wave, int lane) {
    LAS int* tot = (LAS int*)lds; LAS int* pre = tot + 8; LAS int* segb = tot + 16;
    if (tid < 32) tot[tid] = 0;
    __syncthreads();
    if (tid < 256) {
#pragma unroll
        for (int e = 0; e < 8; ++e) { const int c = COUNTS[tid * 8 + e]; atomicAdd((int*)(tot + e), c); if (tid < wg) atomicAdd((int*)(pre + e), c); } }
    __syncthreads();
    if (tid == 0) { int s = 0; for (int e = 0; e < 8; ++e) { segb[e] = s; s += (tot[e] + 255) & ~255; } segb[8] = s;
        if (wg == 0) for (int e = 0; e < 9; ++e) META[e] = segb[e]; }
    __syncthreads();
    const int rowb = wg * 128 + wave * 16;
    for (int i = 0; i < 16; ++i) { const int row = rowb + i; const int4 ri = RI[row];
        const int p1 = segb[ri.x] + pre[ri.x] + ri.z, p2 = segb[ri.y] + pre[ri.y] + ri.w;
        if (lane == 0) POS[row] = make_int2(p1, p2);
        const v4u* s = (const v4u*)(XB + (size_t)row * D); const v4u a = s[lane], c = s[64 + lane];
        v4u* d1 = (v4u*)(XG + (size_t)p1 * D); v4u* d2 = (v4u*)(XG + (size_t)p2 * D);
        d1[lane] = a; d1[64 + lane] = c; d2[lane] = a; d2[64 + lane] = c; }
    __syncthreads();
}
__device__ __forceinline__ void moe_combine_phase(float* X, const bf16* Y, const int2* POS, const f32x2* RG, const float* g, const float* b, int gw, int NGW, int lane) {
    f32x4 gv[4], bv[4];
#pragma unroll
    for (int j = 0; j < 4; ++j) { gv[j] = ((const f32x4*)g)[lane + 64 * j]; bv[j] = ((const f32x4*)b)[lane + 64 * j]; }
    for (int m = gw; m < M; m += NGW) {
        const int2 pos = POS[m]; const f32x2 gg = RG[m];
        f32x4* xr = (f32x4*)(X + (size_t)m * D) + lane; const v2u* y1 = (const v2u*)(Y + (size_t)pos.x * D) + lane; const v2u* y2 = (const v2u*)(Y + (size_t)pos.y * D) + lane;
        f32x4 v[4]; float s = 0.f;
#pragma unroll
        for (int j = 0; j < 4; ++j) { const f32x4 xv = xr[64 * j]; const v2u a = y1[64 * j], c = y2[64 * j];
            v[j].x = ALPHA * xv.x + gg.x * bflo(a.x) + gg.y * bflo(c.x); v[j].y = ALPHA * xv.y + gg.x * bfhi(a.x) + gg.y * bfhi(c.x);
            v[j].z = ALPHA * xv.z + gg.x * bflo(a.y) + gg.y * bflo(c.y); v[j].w = ALPHA * xv.w + gg.x * bfhi(a.y) + gg.y * bfhi(c.y);
            s += (v[j].x + v[j].y) + (v[j].z + v[j].w); }
        const float mean = wave_sum(s) * (1.f / D); float s2 = 0.f;
#pragma unroll
        for (int j = 0; j < 4; ++j) { v[j] = v[j] - mean; s2 += (v[j].x * v[j].x + v[j].y * v[j].y) + (v[j].z * v[j].z + v[j].w * v[j].w); }
        const float rstd = rsqrtf(wave_sum(s2) * (1.f / D) + LN_EPS);
#pragma unroll
        for (int j = 0; j < 4; ++j) xr[64 * j] = v[j] * rstd * gv[j] + bv[j];
    }
}

struct Args { const float* in[22]; float* out; unsigned char* ws; int ph, one, pad0, pad1; };
struct Ctx { int tid, lane, wave, G, bx, vcu, gw, NGW; };
#define RUN() (one || p == args.ph)
#define SEAM() do { if (one) xcd_barrier(bar); ++p; } while (0)
#define SKIP() do { ++p; } while (0)
#define WSP(T, off) ((T*)(ws + (off)))

template <int L> __device__ __forceinline__ void layer_mixer(const Args& args, LAS unsigned char* lds, const XcdBarrier& bar, const bool one, int& p, const Ctx& C) {
    unsigned char* ws = args.ws;
    if (RUN()) {
        pg8::Gemm g{WSP(const bf16, WS_XB), WSP(const bf16, WS_WIN) + (size_t)L * NIN * 1024, M, NIN, D}; pg8::StaticOrder S; S.init(M, NIN, C.G, C.bx);
        pg8::EpiInProj E{WSP(bf16, WS_GLU), WSP(bf16, WS_QKV), WSP(bf16, WS_Z)};
        pg8::gemm_phase<pg8::EpiInProj, pg8::StaticOrder, true, true>(lds, g, S, E);
        gates_phase(WSP(const bf16, WS_XB), WSP(const bf16, WS_WGT) + (size_t)L * 16 * 1024, WSP(float, WS_G8), C.gw, C.NGW, C.lane);
    }
    SEAM();
    if (RUN()) {
        conv_phase(WSP(const bf16, WS_GLU), WSP(bf16, WS_YCAT), args.in[2] + (size_t)L * 31 * 512, args.in[3] + L * 512, args.in[4] + L * 512, args.in[5] + L * 512, lds, C.vcu, C.G, C.wave, C.lane);
        dnpre_phase(WSP(const bf16, WS_QKV), WSP(bf16, WS_QKVN), WSP(const float, WS_G8), WSP(float, WS_GB), WSP(float, WS_GG), args.in[6] + (size_t)L * 4 * 1536, args.in[7] + L * 4, args.in[8] + L * 4, C.gw, C.NGW, C.lane);
    }
    SEAM();
#if DN_NAIVE
    if (RUN()) { if (C.wave == 0 && C.vcu < 256) dn_naive_phase(WSP(const bf16, WS_QKVN), WSP(const float, WS_GB), WSP(const float, WS_GG), WSP(bf16, WS_OL), C.vcu, C.lane); }
    SEAM();
    SKIP();
#else
    SKIP();
    SKIP();
#endif
    if (RUN()) dnnorm_phase(WSP(const bf16, WS_OL), WSP(const bf16, WS_Z), args.in[9] + L * 128, WSP(bf16, WS_YCAT), C.gw, C.NGW, C.lane);
    SEAM();
    if (RUN()) {
        pg8::Gemm g{WSP(const bf16, WS_YCAT), WSP(const bf16, WS_WOUT) + (size_t)L * 1024 * 1024, M, D, D}; pg8::StaticOrder S; S.init(M, D, C.G, C.bx);
        pg8::EpiResid E{L == 0 ? args.in[0] : (const float*)args.out, args.out, ALPHA};
        pg8::gemm_phase<pg8::EpiResid, pg8::StaticOrder, true, true>(lds, g, S, E);
    }
    SEAM();
}

__global__ void __launch_bounds__(NWAVES * 64, 2) fwd_kernel(Args args) {
    extern __shared__ __attribute__((aligned(16))) unsigned char lds_raw[];
    LAS unsigned char* lds = (LAS unsigned char*)lds_raw;
    volatile LAS unsigned* MISC = (volatile LAS unsigned*)(lds + MISC_OFF);
    Ctx C;
    C.tid = threadIdx.x; C.lane = C.tid & 63; C.wave = __builtin_amdgcn_readfirstlane(C.tid >> 6);
    C.G = gridDim.x; C.bx = blockIdx.x; C.vcu = (C.G % 8 == 0) ? (C.bx % 8) * (C.G / 8) + C.bx / 8 : C.bx;
    C.gw = C.vcu * NWAVES + C.wave; C.NGW = C.G * NWAVES;
    unsigned char* ws = args.ws;
    unsigned* ctl = (unsigned*)(ws + WS_CTL);
    for (int u = C.tid; u < (LDS_BYTES - LDSCTL_OFF) / 4; u += NWAVES * 64) ((LAS unsigned*)(lds + LDSCTL_OFF))[u] = 0u;
    __syncthreads();
    const bool one = args.one != 0;
    XcdBarrier bar; bar.bar = ctl + CW_BAR; bar.x = 0; bar.st = nullptr;
    if (one) bar = xcd_barrier_post(ctl + CW_BAR, MISC + 8);
    int p = 0;

    if (RUN()) prologue_phase(args.in[0], args.in[1], args.in[10], args.in[13], args.in[14], args.in[15], ws, lds, C.gw, C.NGW, C.wave, C.lane);
    SEAM();

    layer_mixer<0>(args, lds, bar, one, p, C);
    if (RUN()) ln_phase(args.out, WSP(bf16, WS_XB), args.in[11], args.in[12], C.gw, C.NGW, C.lane);
    SEAM();
    if (RUN()) {
        pg8::Gemm g{WSP(const bf16, WS_XB), WSP(const bf16, WS_WGU0), M, 2 * FF0, D}; pg8::StaticOrder S; S.init(M, 2 * FF0, C.G, C.bx);
        pg8::EpiSwiGLU E{WSP(bf16, WS_HID0), FF0};
        pg8::gemm_phase<pg8::EpiSwiGLU, pg8::StaticOrder, true, true>(lds, g, S, E);
    }
    SEAM();
    if (RUN()) {
        pg8::Gemm g{WSP(const bf16, WS_HID0), WSP(const bf16, WS_WD0), M, D, FF0}; pg8::StaticOrder S; S.init(M, D, C.G, C.bx);
        pg8::EpiResid E{(const float*)args.out, args.out, ALPHA};
        pg8::gemm_phase<pg8::EpiResid, pg8::StaticOrder, true, true>(lds, g, S, E);
    }
    SEAM();
    if (RUN()) ln_phase(args.out, WSP(bf16, WS_XB), args.in[20], args.in[21], C.gw, C.NGW, C.lane);
    SEAM();
    SKIP(); SKIP();

    layer_mixer<1>(args, lds, bar, one, p, C);
    if (RUN()) {
        ln_router_phase(args.out, WSP(bf16, WS_XB), args.in[11] + D, args.in[12] + D, args.in[16], WSP(int4, WS_RI), WSP(f32x2, WS_RG), WSP(int, WS_COUNTS), lds, C.vcu, C.tid, C.wave, C.lane);
        moe_convert_phase(args.in[17], args.in[18], args.in[19], ws, lds, C.gw, C.NGW, C.wave, C.lane);
    }
    SEAM();
    if (RUN()) moe_gather_phase(WSP(const bf16, WS_XB), WSP(bf16, WS_XG), WSP(const int4, WS_RI), WSP(int2, WS_POS), WSP(const int, WS_COUNTS), WSP(int, WS_META), lds, C.vcu, C.tid, C.wave, C.lane);
    SEAM();
    for (int c = 0; c < 5; ++c) {
        asm volatile("" : "+s"(ws));
        int* META = WSP(int, WS_META);
        int tb[9];
#pragma unroll
        for (int e = 0; e < 9; ++e) tb[e] = __builtin_amdgcn_readfirstlane(__hip_atomic_load(META + e, __ATOMIC_RELAXED, __HIP_MEMORY_SCOPE_AGENT)) >> 8;
        const int T = tb[8], t0 = 64 * c, nt = (T - t0) < 64 ? (T - t0) : 64;
        if (RUN() && nt > 0) {
            pg8::MoeOrder<0> S; S.nM = nt; S.nN = 28; S.nwg = nt * 28; S.G = C.G; S.c = C.bx; S.t0 = t0; S.tb1 = tb[1]; S.tb2 = tb[2]; S.tb3 = tb[3]; S.tb4 = tb[4]; S.tb5 = tb[5]; S.tb6 = tb[6]; S.tb7 = tb[7];
            pg8::Gemm g{WSP(const bf16, WS_XG), WSP(const bf16, WS_WMGU), 0, 0, D};
            pg8::EpiSwiGLU E{WSP(bf16, WS_HIDM), FFE};
            pg8::gemm_phase<pg8::EpiSwiGLU, pg8::MoeOrder<0>, true, true>(lds, g, S, E);
        }
        if (nt > 0) SEAM(); else SKIP();
        if (RUN() && nt > 0) {
            pg8::MoeOrder<1> S; S.nM = nt; S.nN = 4; S.nwg = nt * 4; S.G = C.G; S.c = C.bx; S.t0 = t0; S.tb1 = tb[1]; S.tb2 = tb[2]; S.tb3 = tb[3]; S.tb4 = tb[4]; S.tb5 = tb[5]; S.tb6 = tb[6]; S.tb7 = tb[7];
            pg8::Gemm g{WSP(const bf16, WS_HIDM), WSP(const bf16, WS_WMD), 0, 0, FFE};
            pg8::EpiBf16 E{WSP(bf16, WS_XG), D};
            pg8::gemm_phase<pg8::EpiBf16, pg8::MoeOrder<1>, true, true>(lds, g, S, E);
        }
        if (nt > 0) SEAM(); else SKIP();
    }
    if (RUN()) moe_combine_phase(args.out, WSP(const bf16, WS_XG), WSP(const int2, WS_POS), WSP(const f32x2, WS_RG), args.in[20] + D, args.in[21] + D, C.gw, C.NGW, C.lane);
}
#undef RUN
#undef SEAM
#undef SKIP

extern "C" void kernel_launch(void* const* d_in, const int* in_sizes, int n_in, void* d_out, int out_size, void* d_ws, size_t ws_size, hipStream_t stream) {
    static int grid = 0;
    if (grid == 0) {
        if (n_in != 22 || in_sizes[0] != M * D || out_size != M * D || ws_size < WS_END) { fprintf(stderr, "kernel_launch: unexpected shapes / workspace (n_in %d, ws %zu < %zu); nothing launched\n", n_in, ws_size, (size_t)WS_END); grid = -1; return; }
        int dev = 0, cus = 0;
        if (hipGetDevice(&dev) != hipSuccess || hipDeviceGetAttribute(&cus, hipDeviceAttributeMultiprocessorCount, dev) != hipSuccess) { grid = -1; return; }
        if (hipFuncSetAttribute((const void*)fwd_kernel, hipFuncAttributeMaxDynamicSharedMemorySize, LDS_BYTES) != hipSuccess) { fprintf(stderr, "kernel_launch: hipFuncSetAttribute failed\n"); grid = -1; return; }
        (void)hipGetLastError();
        if (cus != 256) { fprintf(stderr, "kernel_launch: built for 256 CUs, device has %d; nothing launched\n", cus); grid = -1; return; }
        grid = cus;
    }
    if (grid < 0) return;
    if (hipMemsetAsync((char*)d_ws + WS_CTL, 0, CTL_ZERO_BYTES, stream) != hipSuccess) return;
    Args a{};
    for (int i = 0; i < 22; ++i) a.in[i] = (const float*)d_in[i];
    a.out = (float*)d_out; a.ws = (unsigned char*)d_ws;
#if MK_N_LAUNCHES == 1
    a.ph = 0; a.one = 1;
    hipLaunchKernelGGL(fwd_kernel, dim3(grid), dim3(NWAVES * 64), LDS_BYTES, stream, a);
#else
    for (int ph = 0; ph < NPH; ++ph) { a.ph = ph; a.one = 0; hipLaunchKernelGGL(fwd_kernel, dim3(grid), dim3(NWAVES * 64), LDS_BYTES, stream, a); }
#endif
}
```

```cpp
#include <hip/hip_runtime.h>
#include <cstdio>
#include <cstdint>

#ifndef MK_N_LAUNCHES
#define MK_N_LAUNCHES 1
#endif
#ifndef DN_NAIVE
#define DN_NAIVE 0
#endif

namespace pg8 {
#define PG8_LAS __attribute__((address_space(3)))
typedef unsigned short bf16_t;
typedef short bf16x8 __attribute__((ext_vector_type(8)));
typedef float f32x4 __attribute__((ext_vector_type(4)));
typedef unsigned u32x4 __attribute__((ext_vector_type(4)));
constexpr int BM = 256, BK = 64, HALF = 128, HTB = HALF * BK * 2  , STAGE_BYTES = 8 * HTB, NXCD = 8, WGM = 8;

__host__ __device__ __forceinline__ int lds_byte(int r, int c) { const int st = (r >> 4) * 2 + (c >> 5), rr = r & 15, cc = c & 31, ob = rr * 64 + cc * 2; return st * 1024 + (ob ^ (((ob >> 9) & 1) << 5)); }
__host__ __device__ __forceinline__ void stage_rc(int b, int& R, int& C) { const int st = b / 1024, sb = b % 1024, swz = sb ^ (((sb >> 9) & 1) << 5); R = (st >> 1) * 16 + swz / 64; C = (st & 1) * 32 + (swz % 64) / 2; }
__host__ __device__ __forceinline__ int perm32(int rho) { const int n = rho >> 4, i = rho & 15; return 8 * (i >> 2) + 4 * n + (i & 3); }

struct Unit { int pm, pn, om, on; };
struct Gemm { const bf16_t* A; const bf16_t* Bt; int M, N, K; };

struct StaticOrder {
    int nM, nN, nwg, G, c;
    __device__ __forceinline__ void init(int M, int N, int G_, int c_) { nM = M / BM; nN = N / BM; nwg = nM * nN; G = G_; c = c_; }
    __device__ __forceinline__ bool next(int i, Unit& u) const {
        const long L = (long)i * G + c; if (L >= nwg) return false;
        int wgid = (int)L; { const int q = nwg / NXCD, r = nwg % NXCD, xcd = wgid % NXCD, off = wgid / NXCD; wgid = (xcd < r ? xcd * (q + 1) : r * (q + 1) + (xcd - r) * q) + off; }
        const int nig = WGM * nN, gid = wgid / nig, fm = gid * WGM, gsz = (nM - fm) < WGM ? (nM - fm) : WGM;
        u.pm = fm + ((wgid % nig) % gsz); u.pn = (wgid % nig) / gsz; u.om = u.pm; u.on = u.pn; return true;
    }
    __device__ __forceinline__ void a_ready(const Unit&) const {}
    __device__ __forceinline__ void done(const Unit&) const {}
};
template <int MODE> struct MoeOrder {
    int nM, nN, nwg, G, c, t0; int tb1, tb2, tb3, tb4, tb5, tb6, tb7;
    __device__ __forceinline__ bool next(int i, Unit& u) const {
        const long L = (long)i * G + c; if (L >= nwg) return false;
        int wgid = (int)L; { const int q = nwg / NXCD, r = nwg % NXCD, xcd = wgid % NXCD, off = wgid / NXCD; wgid = (xcd < r ? xcd * (q + 1) : r * (q + 1) + (xcd - r) * q) + off; }
        const int nig = WGM * nN, gid = wgid / nig, fm = gid * WGM, gsz = (nM - fm) < WGM ? (nM - fm) : WGM;
        const int lm = fm + ((wgid % nig) % gsz), ln = (wgid % nig) / gsz, tile = t0 + lm;
        const int e = (tile >= tb1) + (tile >= tb2) + (tile >= tb3) + (tile >= tb4) + (tile >= tb5) + (tile >= tb6) + (tile >= tb7);
        u.pn = e * nN + ln; u.on = ln;
        if (MODE == 0) { u.pm = tile; u.om = lm; } else { u.pm = lm; u.om = tile; }
        return true;
    }
    __device__ __forceinline__ void a_ready(const Unit&) const {}
    __device__ __forceinline__ void done(const Unit&) const {}
};

__device__ __forceinline__ unsigned cvt_pk_bf16(float lo, float hi) { unsigned r; asm volatile("v_cvt_pk_bf16_f32 %0, %1, %2" : "=v"(r) : "v"(lo), "v"(hi)); return r; }
__device__ __forceinline__ float sigmoid_f(float x) { return __builtin_amdgcn_rcpf(1.0f + __expf(-x)); }
__device__ __forceinline__ float silu_f(float x) { return x * sigmoid_f(x); }

struct EpiInProj {
    static constexpr bool PERM = true, AFTER_DRAIN = false;
    bf16_t* GLU; bf16_t* QKV; bf16_t* Z;
    __device__ __forceinline__ void operator()(const f32x4 (&acc)[2][2][4][2], const Unit& u, int wr, int wc, int fr, int fq) const {
        const int row0 = u.om * BM + wr * 64 + fr, cl = wc * 32 + 8 * fq;
        if (u.on < 4) {
#pragma unroll
            for (int ai = 0; ai < 2; ++ai)
#pragma unroll
                for (int m = 0; m < 4; ++m) { bf16_t* rowp = GLU + (size_t)(row0 + ai * HALF + m * 16) * 512 + u.on * 128 + cl;
                    const f32x4 v0 = acc[ai][0][m][0], v1 = acc[ai][0][m][1], g0 = acc[ai][1][m][0], g1 = acc[ai][1][m][1];
                    u32x4 w; w.x = cvt_pk_bf16(v0[0] * sigmoid_f(g0[0]), v0[1] * sigmoid_f(g0[1])); w.y = cvt_pk_bf16(v0[2] * sigmoid_f(g0[2]), v0[3] * sigmoid_f(g0[3]));
                    w.z = cvt_pk_bf16(v1[0] * sigmoid_f(g1[0]), v1[1] * sigmoid_f(g1[1])); w.w = cvt_pk_bf16(v1[2] * sigmoid_f(g1[2]), v1[3] * sigmoid_f(g1[3]));
                    *(u32x4*)rowp = w; }
        } else if (u.on < 10) {
#pragma unroll
            for (int ai = 0; ai < 2; ++ai)
#pragma unroll
                for (int m = 0; m < 4; ++m) { bf16_t* rowp = QKV + (size_t)(row0 + ai * HALF + m * 16) * 1536 + (u.on - 4) * 256 + cl;
#pragma unroll
                    for (int bj = 0; bj < 2; ++bj) { const f32x4 v0 = acc[ai][bj][m][0], v1 = acc[ai][bj][m][1];
                        u32x4 w; w.x = cvt_pk_bf16(v0[0], v0[1]); w.y = cvt_pk_bf16(v0[2], v0[3]); w.z = cvt_pk_bf16(v1[0], v1[1]); w.w = cvt_pk_bf16(v1[2], v1[3]);
                        *(u32x4*)(rowp + bj * HALF) = w; } }
        } else {
#pragma unroll
            for (int ai = 0; ai < 2; ++ai)
#pragma unroll
                for (int m = 0; m < 4; ++m) { bf16_t* rowp = Z + (size_t)(row0 + ai * HALF + m * 16) * 512 + (u.on - 10) * 256 + cl;
#pragma unroll
                    for (int bj = 0; bj < 2; ++bj) { const f32x4 v0 = acc[ai][bj][m][0], v1 = acc[ai][bj][m][1];
                        u32x4 w; w.x = cvt_pk_bf16(silu_f(v0[0]), silu_f(v0[1])); w.y = cvt_pk_bf16(silu_f(v0[2]), silu_f(v0[3])); w.z = cvt_pk_bf16(silu_f(v1[0]), silu_f(v1[1])); w.w = cvt_pk_bf16(silu_f(v1[2]), silu_f(v1[3]));
                        *(u32x4*)(rowp + bj * HALF) = w; } }
        }
    }
};
struct EpiSwiGLU {
    static constexpr bool PERM = true, AFTER_DRAIN = false;
    bf16_t* H; int ldh;
    __device__ __forceinline__ void operator()(const f32x4 (&acc)[2][2][4][2], const Unit& u, int wr, int wc, int fr, int fq) const {
        const int row0 = u.om * BM + wr * 64 + fr, cl = u.on * 128 + wc * 32 + 8 * fq;
#pragma unroll
        for (int ai = 0; ai < 2; ++ai)
#pragma unroll
            for (int m = 0; m < 4; ++m) { bf16_t* rowp = H + (size_t)(row0 + ai * HALF + m * 16) * ldh + cl;
                const f32x4 g0 = acc[ai][0][m][0], g1 = acc[ai][0][m][1], u0 = acc[ai][1][m][0], u1 = acc[ai][1][m][1];
                u32x4 w; w.x = cvt_pk_bf16(silu_f(g0[0]) * u0[0], silu_f(g0[1]) * u0[1]); w.y = cvt_pk_bf16(silu_f(g0[2]) * u0[2], silu_f(g0[3]) * u0[3]);
                w.z = cvt_pk_bf16(silu_f(g1[0]) * u1[0], silu_f(g1[1]) * u1[1]); w.w = cvt_pk_bf16(silu_f(g1[2]) * u1[2], silu_f(g1[3]) * u1[3]);
                *(u32x4*)rowp = w; }
    }
};
struct EpiBf16 {
    static constexpr bool PERM = true, AFTER_DRAIN = false;
    bf16_t* O; int ldc;
    __device__ __forceinline__ void operator()(const f32x4 (&acc)[2][2][4][2], const Unit& u, int wr, int wc, int fr, int fq) const {
        const int row0 = u.om * BM + wr * 64 + fr, cl = u.on * BM + wc * 32 + 8 * fq;
#pragma unroll
        for (int ai = 0; ai < 2; ++ai)
#pragma unroll
            for (int m = 0; m < 4; ++m) { bf16_t* rowp = O + (size_t)(row0 + ai * HALF + m * 16) * ldc + cl;
#pragma unroll
                for (int bj = 0; bj < 2; ++bj) { const f32x4 v0 = acc[ai][bj][m][0], v1 = acc[ai][bj][m][1];
                    u32x4 w; w.x = cvt_pk_bf16(v0[0], v0[1]); w.y = cvt_pk_bf16(v0[2], v0[3]); w.z = cvt_pk_bf16(v1[0], v1[1]); w.w = cvt_pk_bf16(v1[2], v1[3]);
                    *(u32x4*)(rowp + bj * HALF) = w; } }
    }
};
struct EpiResid {
    static constexpr bool PERM = false, AFTER_DRAIN = false;
    const float* res; float* out; float alpha;
    __device__ __forceinline__ void operator()(const f32x4 (&acc)[2][2][4][2], const Unit& u, int wr, int wc, int fr, int fq) const {
        const int row0 = u.om * BM + wr * 64 + fr, col0 = u.on * BM + wc * 32 + 4 * fq;
#pragma unroll
        for (int ai = 0; ai < 2; ++ai)
#pragma unroll
            for (int m = 0; m < 4; ++m) { const size_t off = (size_t)(row0 + ai * HALF + m * 16) * 1024 + col0;
#pragma unroll
                for (int bj = 0; bj < 2; ++bj)
#pragma unroll
                    for (int n = 0; n < 2; ++n) { const f32x4 r = *(const f32x4*)(res + off + bj * HALF + n * 16); *(f32x4*)(out + off + bj * HALF + n * 16) = r * alpha + acc[ai][bj][m][n]; }
                asm volatile("" ::: "memory"); }
    }
};

template <class Epi, class Sched, bool ALIGN_EPI = false, bool SP2 = false>
__device__ __forceinline__ void gemm_phase(PG8_LAS unsigned char* lds, const Gemm g, const Sched& S, const Epi& E) {
    const int tid = threadIdx.x, wid = __builtin_amdgcn_readfirstlane(tid >> 6), lane = tid & 63, wr = wid >> 2, wc = wid & 3, fr = lane & 15, fq = lane >> 4;
    const int K = g.K, nt = K / BK;
    unsigned voffA[2], voffB[2];
#pragma unroll
    for (int i = 0; i < 2; ++i) { int R, C; stage_rc(tid * 16 + i * 8192, R, C); const int Rb = Epi::PERM ? ((R & ~31) + perm32(R & 31)) : R;
        voffA[i] = (unsigned)(R * K + C) * 2u; voffB[i] = (unsigned)(Rb * K + C) * 2u; }
    const size_t kstep = (size_t)(BK * 2);
    const size_t hstep = (size_t)HALF * K * 2;
    const size_t tstep = 2 * hstep;
    const unsigned ldsw = (unsigned)wid * 1024u;
    const int aoff = lds_byte(wr * 64 + fr, fq * 8), boff = lds_byte(wc * 32 + fr, fq * 8);
#define PG8_SA(b, h) (((b) * 2 + (h)) * HTB)
#define PG8_SB(b, h) ((4 + (b) * 2 + (h)) * HTB)
#define PG8_STAGE(bufoff, gbase, voff) do { _Pragma("unroll") for (int _i = 0; _i < 2; ++_i) \
        __builtin_amdgcn_global_load_lds((const unsigned*)((const char*)(gbase) + (voff)[_i]), (PG8_LAS unsigned*)(lds + (bufoff) + ldsw + _i * 8192), 16, 0, 0); } while (0)
#define PG8_LDA(dst, b, h) do { _Pragma("unroll") for (int m = 0; m < 4; ++m) _Pragma("unroll") for (int k = 0; k < 2; ++k) dst[m][k] = *(const PG8_LAS bf16x8*)(lds + PG8_SA(b, h) + aoff + m * 2048 + k * 1024); } while (0)
#define PG8_LDB(dst, b, h) do { _Pragma("unroll") for (int n = 0; n < 2; ++n) _Pragma("unroll") for (int k = 0; k < 2; ++k) dst[n][k] = *(const PG8_LAS bf16x8*)(lds + PG8_SB(b, h) + boff + n * 2048 + k * 1024); } while (0)
#define PG8_MMA(ai, bj, At, Bt) do { __builtin_amdgcn_s_setprio(1); _Pragma("unroll") for (int m = 0; m < 4; ++m) _Pragma("unroll") for (int n = 0; n < 2; ++n) _Pragma("unroll") for (int k = 0; k < 2; ++k) \
        acc[ai][bj][m][n] = __builtin_amdgcn_mfma_f32_16x16x32_bf16(Bt[n][k], At[m][k], acc[ai][bj][m][n], 0, 0, 0); __builtin_amdgcn_s_setprio(0); } while (0)
#define PG8_WAIT_V(n) asm volatile("s_waitcnt vmcnt(" #n ")" ::: "memory")
#define PG8_WAIT_L(n) asm volatile("s_waitcnt lgkmcnt(" #n ")" ::: "memory")
#define PG8_BAR __builtin_amdgcn_s_barrier()
#define PG8_SCHED __builtin_amdgcn_sched_barrier(0)
    Unit cur, nxt; int ui = 0;
    if (!S.next(0, cur)) return;
    f32x4 acc[2][2][4][2];
#pragma unroll
    for (int a = 0; a < 2; ++a)
#pragma unroll
        for (int b = 0; b < 2; ++b)
#pragma unroll
            for (int m = 0; m < 4; ++m)
#pragma unroll
                for (int n = 0; n < 2; ++n) acc[a][b][m][n] = (f32x4){0.f, 0.f, 0.f, 0.f};
    bf16x8 At[4][2], B0[2][2], B1[2][2];
    const char* cA = (const char*)g.A + (size_t)cur.pm * tstep; const char* cB = (const char*)g.Bt + (size_t)cur.pn * tstep;
    S.a_ready(cur);
    if constexpr (SP2) {
        PG8_STAGE(PG8_SB(0, 0), cB, voffB); PG8_STAGE(PG8_SB(0, 1), cB + hstep, voffB); PG8_STAGE(PG8_SA(0, 0), cA, voffA); PG8_STAGE(PG8_SA(0, 1), cA + hstep, voffA);
        if (wr == 1) PG8_BAR;
        PG8_WAIT_V(2); PG8_BAR;
        PG8_STAGE(PG8_SB(1, 0), cB + kstep, voffB); PG8_STAGE(PG8_SA(1, 0), cA + kstep, voffA); PG8_STAGE(PG8_SB(1, 1), cB + hstep + kstep, voffB);
        PG8_WAIT_V(6); PG8_BAR;
    } else {
        PG8_STAGE(PG8_SB(0, 0), cB, voffB); PG8_STAGE(PG8_SA(0, 0), cA, voffA); PG8_STAGE(PG8_SB(0, 1), cB + hstep, voffB); PG8_STAGE(PG8_SA(0, 1), cA + hstep, voffA);
        if (wr == 1) PG8_BAR;
        PG8_WAIT_V(4); PG8_BAR;
        PG8_STAGE(PG8_SB(1, 0), cB + kstep, voffB); PG8_STAGE(PG8_SA(1, 0), cA + kstep, voffA); PG8_STAGE(PG8_SB(1, 1), cB + hstep + kstep, voffB);
        PG8_WAIT_V(6); PG8_BAR;
    }
    for (;;) {
        const bool has_next = S.next(ui + 1, nxt);
        const char* nA = has_next ? (const char*)g.A + (size_t)nxt.pm * tstep : cA; const char* nB = has_next ? (const char*)g.Bt + (size_t)nxt.pn * tstep : cB;
        for (int t = 0; t < nt; t += 2) {
            const bool last = (t == nt - 2);
            const char* a1 = cA + (size_t)(t + 1) * kstep;
            const char* a2 = last ? nA : cA + (size_t)(t + 2) * kstep; const char* b2 = last ? nB : cB + (size_t)(t + 2) * kstep;
            const char* a3 = a2 + kstep; const char* b3 = b2 + kstep;
            if (last && has_next) S.a_ready(nxt);
            if constexpr (SP2) {
            PG8_LDB(B0, 0, 0); PG8_LDB(B1, 0, 1); PG8_SCHED; PG8_LDA(At, 0, 0); PG8_STAGE(PG8_SA(1, 1), a1 + hstep, voffA);
            PG8_WAIT_V(8); PG8_WAIT_L(0); PG8_BAR; PG8_MMA(0, 0, At, B0); PG8_MMA(0, 1, At, B1); PG8_BAR; PG8_SCHED;
            PG8_LDA(At, 0, 1); PG8_STAGE(PG8_SB(0, 0), b2, voffB); PG8_STAGE(PG8_SB(0, 1), b2 + hstep, voffB); PG8_STAGE(PG8_SA(0, 0), a2, voffA);
            PG8_WAIT_V(8); PG8_WAIT_L(0); PG8_BAR; PG8_MMA(1, 0, At, B0); PG8_MMA(1, 1, At, B1); PG8_BAR; PG8_SCHED;
            PG8_LDB(B0, 1, 0); PG8_LDB(B1, 1, 1); PG8_SCHED; PG8_LDA(At, 1, 0); PG8_STAGE(PG8_SA(0, 1), a2 + hstep, voffA);
            PG8_WAIT_V(8); PG8_WAIT_L(0); PG8_BAR; PG8_MMA(0, 0, At, B0); PG8_MMA(0, 1, At, B1); PG8_BAR; PG8_SCHED;
            PG8_LDA(At, 1, 1); PG8_STAGE(PG8_SB(1, 0), b3, voffB); PG8_STAGE(PG8_SB(1, 1), b3 + hstep, voffB); PG8_STAGE(PG8_SA(1, 0), a3, voffA);
            PG8_WAIT_V(8); PG8_WAIT_L(0); PG8_BAR; PG8_MMA(1, 0, At, B0); PG8_MMA(1, 1, At, B1); PG8_BAR; PG8_SCHED;
            } else {
            PG8_LDB(B0, 0, 0); PG8_SCHED; PG8_LDA(At, 0, 0); PG8_STAGE(PG8_SA(1, 1), a1 + hstep, voffA);
            PG8_WAIT_L(8); PG8_BAR; PG8_WAIT_L(0); PG8_MMA(0, 0, At, B0); PG8_BAR; PG8_SCHED;
            PG8_LDB(B1, 0, 1); PG8_STAGE(PG8_SB(0, 0), b2, voffB);
            PG8_BAR; PG8_WAIT_L(0); PG8_MMA(0, 1, At, B1); PG8_BAR;
            PG8_LDA(At, 0, 1); PG8_STAGE(PG8_SA(0, 0), a2, voffA);
            PG8_BAR; PG8_WAIT_L(0); PG8_MMA(1, 0, At, B0); PG8_BAR; PG8_SCHED;
            PG8_STAGE(PG8_SB(0, 1), b2 + hstep, voffB);
            PG8_WAIT_V(6); PG8_BAR; PG8_MMA(1, 1, At, B1); PG8_BAR;
            PG8_LDB(B0, 1, 0); PG8_SCHED; PG8_LDA(At, 1, 0); PG8_STAGE(PG8_SA(0, 1), a2 + hstep, voffA);
            PG8_WAIT_L(8); PG8_BAR; PG8_WAIT_L(0); PG8_MMA(0, 0, At, B0); PG8_BAR; PG8_SCHED;
            PG8_LDB(B1, 1, 1); PG8_STAGE(PG8_SB(1, 0), b3, voffB);
            PG8_BAR; PG8_WAIT_L(0); PG8_MMA(0, 1, At, B1); PG8_BAR;
            PG8_LDA(At, 1, 1); PG8_STAGE(PG8_SA(1, 0), a3, voffA);
            PG8_BAR; PG8_WAIT_L(0); PG8_MMA(1, 0, At, B0); PG8_BAR; PG8_SCHED;
            PG8_STAGE(PG8_SB(1, 1), b3 + hstep, voffB);
            PG8_WAIT_V(6); PG8_BAR; PG8_MMA(1, 1, At, B1); PG8_BAR;
            }
        }
        if constexpr (ALIGN_EPI) { if (wr == 0) PG8_BAR; }
        if constexpr (!Epi::AFTER_DRAIN) { E(acc, cur, wr, wc, fr, fq); S.done(cur); }
        if (!has_next) break;
#pragma unroll
        for (int a = 0; a < 2; ++a)
#pragma unroll
            for (int b = 0; b < 2; ++b)
#pragma unroll
                for (int m = 0; m < 4; ++m)
#pragma unroll
                    for (int n = 0; n < 2; ++n) acc[a][b][m][n] = (f32x4){0.f, 0.f, 0.f, 0.f};
        cur = nxt; cA = nA; cB = nB; ++ui;
        if constexpr (ALIGN_EPI) { if (wr == 1) PG8_BAR; }
    }
    PG8_WAIT_V(0);
    if constexpr (!ALIGN_EPI) { if (wr == 0) PG8_BAR; }
    PG8_BAR;
    if constexpr (Epi::AFTER_DRAIN) { E.fused(acc, cur, wr, wc, fr, fq, lds, wid, lane); S.done(cur); }
#undef PG8_SA
#undef PG8_SB
#undef PG8_STAGE
#undef PG8_LDA
#undef PG8_LDB
#undef PG8_MMA
#undef PG8_WAIT_V
#undef PG8_WAIT_L
#undef PG8_BAR
#undef PG8_SCHED
}
}

constexpr int NWAVES = 8;
constexpr int BATCH = 2, SEQ = 16384, D = 1024, M = BATCH * SEQ;
constexpr int NIN = 3072, IN_COLS = 3080, FF0 = 2816, NE = 8, FFE = 3584;
constexpr float LN_EPS = 1e-5f;
constexpr float ALPHA = 1.41421356237309515f;
constexpr int NPH = 32;
constexpr size_t MiB = 1u << 20;
constexpr size_t WS_CTL = 0, CTL_ZERO_BYTES = 1 * MiB;
constexpr size_t WS_WGT = 1 * MiB;
constexpr size_t WS_COUNTS = 1 * MiB + 65536;
constexpr size_t WS_META = WS_COUNTS + 8192;
constexpr size_t WS_G8 = 2 * MiB;
constexpr size_t WS_GB = 3 * MiB;
constexpr size_t WS_GG = 3 * MiB + 512 * 1024;
constexpr size_t WS_RI = 4 * MiB;
constexpr size_t WS_RG = 4 * MiB + 512 * 1024;
constexpr size_t WS_POS = 4 * MiB + 768 * 1024;
constexpr size_t WS_WIN = 6 * MiB;
constexpr size_t WS_WOUT = 18 * MiB;
constexpr size_t WS_WGU0 = 22 * MiB;
constexpr size_t WS_WD0 = 33 * MiB;
constexpr size_t WS_XB = 40 * MiB;
constexpr size_t WS_OL = 40 * MiB;
constexpr size_t WS_QT = 72 * MiB;
constexpr size_t WS_R = 104 * MiB;
constexpr size_t WS_GLU = WS_R, WS_Z = WS_R + 32 * MiB, WS_YCAT = WS_R + 64 * MiB, WS_QKVN = WS_R + 128 * MiB, WS_QKV = WS_R + 224 * MiB;
constexpr size_t WS_MC = WS_R + 224 * MiB;
constexpr size_t WS_HID0 = WS_R;
constexpr size_t WS_WMGU = WS_R, WS_WMD = WS_R + 112 * MiB, WS_XG = WS_R + 168 * MiB, WS_HIDM = WS_R + 300 * MiB, WS_END = WS_R + 412 * MiB;
constexpr int XG_ROWS = 2 * M + NE * 256;
static_assert(WS_XG + (size_t)XG_ROWS * D * 2 <= WS_HIDM && WS_HIDM + (size_t)16384 * FFE * 2 <= WS_END, "ws map");
constexpr int CW_BAR = 4096;
constexpr int RING_BYTES = 131072, LDSCTL_OFF = 143360, MISC_OFF = LDSCTL_OFF + 320, LDS_BYTES = 147456;

#define LAS __attribute__((address_space(3)))
typedef unsigned short bf16;
typedef unsigned v4u __attribute__((ext_vector_type(4)));
typedef unsigned v2u __attribute__((ext_vector_type(2)));
typedef float f32x4 __attribute__((ext_vector_type(4)));
typedef float f32x2 __attribute__((ext_vector_type(2)));
typedef short bf16x8 __attribute__((ext_vector_type(8)));
#define LDS_WAIT() asm volatile("s_waitcnt lgkmcnt(0)" ::: "memory")
__device__ __forceinline__ unsigned f2bf(float f) { unsigned u = __builtin_bit_cast(unsigned, f); return (u + 0x7fffu + ((u >> 16) & 1u)) >> 16; }
__device__ __forceinline__ unsigned pk2(float lo, float hi) { return f2bf(lo) | (f2bf(hi) << 16); }
__device__ __forceinline__ float bflo(unsigned u) { return __builtin_bit_cast(float, u << 16); }
__device__ __forceinline__ float bfhi(unsigned u) { return __builtin_bit_cast(float, u & 0xffff0000u); }
__device__ __forceinline__ float wave_sum(float v) {
#pragma unroll
    for (int o = 1; o < 64; o <<= 1) v += __shfl_xor(v, o);
    return v;
}
__device__ __forceinline__ float sigm(float x) { return 1.0f / (1.0f + __expf(-x)); }

#define XB_TMO      128
#define XB_XCNT(j)  (256  + 64 * (j))
#define XB_XSUB(j)  (1280 + 64 * (j))
#define XB_XGEN(j)  (2304 + 64 * (j))
#define XB_TOP      3328
#define XB_TOPGEN   3392
#define XCD_BAR_WORDS 3456
#define XB_SPIN_CAP (1u << 18)
__device__ __forceinline__ unsigned xb_ld(unsigned* p)              { return __hip_atomic_load(p, __ATOMIC_RELAXED, __HIP_MEMORY_SCOPE_AGENT); }
__device__ __forceinline__ unsigned xb_add(unsigned* p, unsigned v) { return __hip_atomic_fetch_add(p, v, __ATOMIC_RELAXED, __HIP_MEMORY_SCOPE_AGENT); }
__device__ __forceinline__ unsigned xb_xcc_id() { return (unsigned)__builtin_amdgcn_s_getreg((3 << 11) | 20) & 0xFu; }
#define XB_SPIN(cond, bar) do { unsigned _sp = 0; while (cond) { __builtin_amdgcn_s_sleep(1); \
    if ((++_sp & 255u) == 0u) { if (xb_ld(&(bar)[XB_TMO])) break; if (_sp > XB_SPIN_CAP) { atomicAdd(&(bar)[XB_TMO], 1u); break; } } } } while (0)
struct XcdBarrier { unsigned* bar; unsigned x; volatile LAS unsigned* st; };
__device__ __forceinline__ XcdBarrier xcd_barrier_post(unsigned* bar, volatile LAS unsigned* st) {
    XcdBarrier b; b.bar = bar; b.x = xb_xcc_id(); b.st = st;
    if (threadIdx.x == 0) (void)xb_add(&bar[XB_XCNT(b.x)], 1u);
    return b;
}
__device__ __forceinline__ void xcd_barrier_complete(unsigned* bar, unsigned x, unsigned& nloc, unsigned& nx) {
    const unsigned G = gridDim.x * gridDim.y * gridDim.z;
    unsigned sum, cnt, mine, sp = 0u;
    for (;;) {
        sum = 0u; cnt = 0u; mine = 0u;
#pragma unroll
        for (unsigned j = 0; j < 16; ++j) { const unsigned c = xb_ld(&bar[XB_XCNT(j)]); sum += c; cnt += (c > 0u) ? 1u : 0u; mine = (j == x) ? c : mine; }
        if (sum == G) break;
        __builtin_amdgcn_s_sleep(1);
        if ((++sp & 255u) == 0u) { if (xb_ld(&bar[XB_TMO])) break; if (sp > XB_SPIN_CAP) { atomicAdd(&bar[XB_TMO], 1u); break; } }
    }
    nloc = mine > 0u ? mine : 1u; nx = cnt > 0u ? cnt : 1u;
}
__device__ __forceinline__ void xcd_barrier(const XcdBarrier& b) {
    asm volatile("s_waitcnt vmcnt(0)" ::: "memory");
    __syncthreads();
    if (threadIdx.x == 0) {
        unsigned* bar = b.bar;
        __builtin_amdgcn_s_waitcnt(0);
        unsigned nloc = b.st[0], nx = b.st[1];
        if (nloc == 0u) { xcd_barrier_complete(bar, b.x, nloc, nx); b.st[0] = nloc; b.st[1] = nx; }
        const unsigned old = xb_add(&bar[XB_XSUB(b.x)], 1u);
        const unsigned gen = old / nloc;
        if (old + 1u == (gen + 1u) * nloc) {
            __builtin_amdgcn_fence(__ATOMIC_RELEASE, "agent");
            asm volatile("s_waitcnt vmcnt(0)" ::: "memory");
            const unsigned og = xb_add(&bar[XB_TOP], 1u);
            const unsigned tg = og / nx;
            if (og + 1u == (tg + 1u) * nx) xb_add(&bar[XB_TOPGEN], 1u);
            else XB_SPIN(xb_ld(&bar[XB_TOPGEN]) == tg, bar);
            __builtin_amdgcn_fence(__ATOMIC_ACQUIRE, "agent");
            xb_add(&bar[XB_XGEN(b.x)], 1u);
            asm volatile("s_waitcnt vmcnt(0)" ::: "memory");
        } else {
            XB_SPIN(xb_ld(&bar[XB_XGEN(b.x)]) == gen, bar);
            __builtin_amdgcn_fence(__ATOMIC_ACQUIRE, "agent");
            asm volatile("s_waitcnt vmcnt(0)" ::: "memory");
        }
    }
    __syncthreads();
}

__device__ __forceinline__ void transpose_item(const float* W, int ldw, bf16* WT, int Kd, int k0, int n0, int drow0, LAS float* scr, int lane) {
#pragma unroll 8
    for (int i = 0; i < 32; ++i) { const int kk = 2 * i + (lane >> 5); scr[kk * 33 + (lane & 31)] = W[(size_t)(k0 + kk) * ldw + n0 + (lane & 31)]; }
    LDS_WAIT();
    const int c = lane & 7;
#pragma unroll
    for (int j = 0; j < 4; ++j) { const int n = (lane >> 3) + 8 * j; const LAS float* s = scr + (8 * c) * 33 + n;
        v4u o; o.x = pk2(s[0 * 33], s[1 * 33]); o.y = pk2(s[2 * 33], s[3 * 33]); o.z = pk2(s[4 * 33], s[5 * 33]); o.w = pk2(s[6 * 33], s[7 * 33]);
        *(v4u*)(WT + (size_t)(drow0 + n) * Kd + k0 + 8 * c) = o; }
    LDS_WAIT();
}
__device__ __forceinline__ void convert_ffn_item(const float* Wg, const float* Wu, const float* Wd, int F, bf16* WGU, bf16* WD, int r, LAS float* scr, int lane) {
    const int per = 16 * (F / 32);
    const int which = r / per, blk = r % per;
    if (which < 2) { const int nblk = F / 32, kb = blk / nblk, nb = blk % nblk, n0 = 32 * nb;
        transpose_item(which ? Wu : Wg, F, WGU, 1024, 64 * kb, n0, 256 * (n0 >> 7) + (n0 & 127) + (which ? 128 : 0), scr, lane); }
    else { const int kb = blk / 32, nb = blk % 32; transpose_item(Wd, 1024, WD, F, 64 * kb, 32 * nb, 32 * nb, scr, lane); }
}

__device__ __forceinline__ void prologue_phase(const float* x, const float* w_in, const float* w_out, const float* fg, const float* fu, const float* fd, unsigned char* ws, LAS unsigned char* lds, int gw, int NGW, int wave, int lane) {
    LAS float* scr = (LAS float*)(lds + wave * 16384);
    for (int it = gw; it < 2 * 16 * 96; it += NGW) { const int l = it / 1536, r = it % 1536, kb = r / 96, nb = r % 96, n0 = 32 * nb;
        const int drow0 = n0 < 512 ? 256 * (n0 >> 7) + (n0 & 127) : (n0 < 1024 ? 256 * ((n0 - 512) >> 7) + 128 + (n0 & 127) : n0);
        transpose_item(w_in + (size_t)l * 1024 * IN_COLS, IN_COLS, (bf16*)(ws + WS_WIN) + (size_t)l * NIN * 1024, 1024, 64 * kb, n0, drow0, scr, lane); }
    for (int it = gw; it < 2 * 16 * 32; it += NGW) { const int l = it / 512, r = it % 512, kb = r / 32, nb = r % 32;
        transpose_item(w_out + (size_t)l * 1024 * 1024, 1024, (bf16*)(ws + WS_WOUT) + (size_t)l * 1024 * 1024, 1024, 64 * kb, 32 * nb, 32 * nb, scr, lane); }
    for (int it = gw; it < 3 * 16 * (FF0 / 32); it += NGW) convert_ffn_item(fg, fu, fd, FF0, (bf16*)(ws + WS_WGU0), (bf16*)(ws + WS_WD0), it, scr, lane);
    { bf16* WGT = (bf16*)(ws + WS_WGT); const int tid = gw * 64 + lane, nth = NGW * 64;
      for (int i = tid; i < 2 * 16 * 1024; i += nth) { const int l = i >> 14, j = (i >> 10) & 15, k = i & 1023; WGT[i] = (bf16)(j < 8 ? f2bf(w_in[(size_t)l * 1024 * IN_COLS + (size_t)k * IN_COLS + NIN + j]) : 0u); } }
    { const f32x4* xs = (const f32x4*)x; v4u* xb = (v4u*)(ws + WS_XB); const size_t tid = (size_t)gw * 64 + lane, nth = (size_t)NGW * 64;
      for (size_t i = tid; i < (size_t)M * D / 8; i += nth) { const f32x4 a = xs[2 * i], b = xs[2 * i + 1]; v4u o; o.x = pk2(a.x, a.y); o.y = pk2(a.z, a.w); o.z = pk2(b.x, b.y); o.w = pk2(b.z, b.w); xb[i] = o; } }
}
__device__ __forceinline__ void moe_convert_phase(const float* mg, const float* mu, const float* md, unsigned char* ws, LAS unsigned char* lds, int gw, int NGW, int wave, int lane) {
    LAS float* scr = (LAS float*)(lds + wave * 16384);
    constexpr int PER_E = 3 * 16 * (FFE / 32);
    for (int it = gw; it < NE * PER_E; it += NGW) { const int e = it / PER_E, r = it % PER_E;
        convert_ffn_item(mg + (size_t)e * 1024 * FFE, mu + (size_t)e * 1024 * FFE, md + (size_t)e * FFE * 1024, FFE, (bf16*)(ws + WS_WMGU) + (size_t)e * 2 * FFE * 1024, (bf16*)(ws + WS_WMD) + (size_t)e * 1024 * FFE, r, scr, lane); }
}
__device__ __forceinline__ void gates_phase(const bf16* XB, const bf16* WgT, float* G8, int gw, int NGW, int lane) {
    for (int tg = gw; tg < M / 16; tg += NGW) {
        const int t0 = tg * 16; f32x4 acc = {0.f, 0.f, 0.f, 0.f};
        const bf16* ap = XB + (size_t)(t0 + (lane & 15)) * D + 8 * (lane >> 4);
        const bf16* bp = WgT + (size_t)(lane & 15) * D + 8 * (lane >> 4);
#pragma unroll 8
        for (int s = 0; s < 32; ++s) { const bf16x8 a = *(const bf16x8*)(ap + 32 * s), b = *(const bf16x8*)(bp + 32 * s); acc = __builtin_amdgcn_mfma_f32_16x16x32_bf16(a, b, acc, 0, 0, 0); }
        if ((lane & 15) < 8) {
#pragma unroll
            for (int i = 0; i < 4; ++i) G8[(size_t)(t0 + 4 * (lane >> 4) + i) * 8 + (lane & 15)] = acc[i]; }
    }
}
__device__ __forceinline__ void conv_phase(const bf16* GLU, bf16* YCAT, const float* dw_w, const float* dw_b, const float* lg, const float* lb, LAS unsigned char* lds, int item0, int istride, int wave, int lane) {
    const int cg = wave & 3, th = wave >> 2, c0 = cg * 128 + 2 * lane;
    float w0[31], w1[31];
#pragma unroll
    for (int j = 0; j < 31; ++j) { const f32x2 w = *(const f32x2*)(dw_w + j * 512 + c0); w0[j] = w.x; w1[j] = w.y; }
    const f32x2 bias = *(const f32x2*)(dw_b + c0), gam = *(const f32x2*)(lg + c0), bet = *(const f32x2*)(lb + c0);
    LAS f32x2* part = (LAS f32x2*)lds;
    int buf = 0;
    for (int item = item0; item < M / 64; item += istride) {
        const int b = item >> 8, n = item & 255;
        for (int tb = 0; tb < 4; ++tb) {
            const int tl = n * 64 + th * 32 + tb * 8;
            unsigned in[38];
#pragma unroll
            for (int r = 0; r < 38; ++r) { const int t = tl - 30 + r; const unsigned v = *(const unsigned*)(GLU + (size_t)(b * SEQ + (t < 0 ? 0 : t)) * 512 + c0); in[r] = (t >= 0) ? v : 0u; }
            float a0[8], a1[8];
#pragma unroll
            for (int i = 0; i < 8; ++i) { a0[i] = bias.x; a1[i] = bias.y; }
#pragma unroll
            for (int r = 0; r < 38; ++r) { const float x0 = bflo(in[r]), x1 = bfhi(in[r]);
#pragma unroll
                for (int i = 0; i < 8; ++i) { const int j = r - i; if (j >= 0 && j <= 30) { a0[i] += w0[j] * x0; a1[i] += w1[j] * x1; } } }
#pragma unroll
            for (int i = 0; i < 8; ++i) { const float s = wave_sum(a0[i] + a1[i]), q = wave_sum(a0[i] * a0[i] + a1[i] * a1[i]);
                if (lane == 0) part[((buf * 2 + th) * 8 + i) * 4 + cg] = (f32x2){s, q}; }
            __syncthreads();
#pragma unroll
            for (int i = 0; i < 8; ++i) { const LAS f32x2* pp = part + ((buf * 2 + th) * 8 + i) * 4; const f32x2 p0 = pp[0], p1 = pp[1], p2 = pp[2], p3 = pp[3];
                const float mean = ((p0.x + p1.x) + (p2.x + p3.x)) * (1.f / 512.f), ex2 = ((p0.y + p1.y) + (p2.y + p3.y)) * (1.f / 512.f);
                const float rstd = rsqrtf(fmaxf(ex2 - mean * mean, 0.f) + LN_EPS);
                const float y0 = (a0[i] - mean) * rstd * gam.x + bet.x, y1 = (a1[i] - mean) * rstd * gam.y + bet.y;
                *(unsigned*)(YCAT + (size_t)(b * SEQ + tl + i) * D + c0) = pk2(y0 * sigm(y0), y1 * sigm(y1)); }
            buf ^= 1;
        }
    }
}
__device__ __forceinline__ void dnpre_phase(const bf16* QKV, bf16* QKVN, const float* G8, float* GB, float* GG, const float* scw, const float* a_log, const float* dt_bias, int gw, int NGW, int lane) {
    for (int it = gw; it < (M / 16) * 4; it += NGW) {
        const int h = it & 3, row0 = (it >> 2) * 16, tl0 = row0 & (SEQ - 1), ch = h * 128 + 2 * lane;
        f32x2 wq[4], wk[4], wv[4];
#pragma unroll
        for (int j = 0; j < 4; ++j) { wq[j] = *(const f32x2*)(scw + j * 1536 + ch); wk[j] = *(const f32x2*)(scw + j * 1536 + 512 + ch); wv[j] = *(const f32x2*)(scw + j * 1536 + 1024 + ch); }
        const float nA = -__expf(a_log[h]), dtb = dt_bias[h];
        for (int i = 0; i < 16; ++i) {
            const int row = row0 + i, tl = tl0 + i;
            float q0 = 0.f, q1 = 0.f, k0 = 0.f, k1 = 0.f, v0 = 0.f, v1 = 0.f;
#pragma unroll
            for (int j = 0; j < 4; ++j) { if (tl - 3 + j >= 0) { const bf16* p = QKV + (size_t)(row - 3 + j) * 1536 + ch;
                const unsigned uq = *(const unsigned*)p, uk = *(const unsigned*)(p + 512), uv = *(const unsigned*)(p + 1024);
                q0 += wq[j].x * bflo(uq); q1 += wq[j].y * bfhi(uq); k0 += wk[j].x * bflo(uk); k1 += wk[j].y * bfhi(uk); v0 += wv[j].x * bflo(uv); v1 += wv[j].y * bfhi(uv); } }
            q0 *= sigm(q0); q1 *= sigm(q1); k0 *= sigm(k0); k1 *= sigm(k1); v0 *= sigm(v0); v1 *= sigm(v1);
            const float sq = wave_sum(q0 * q0 + q1 * q1), sk = wave_sum(k0 * k0 + k1 * k1);
            const float rq = rsqrtf(sq + 1e-6f) * 0.08838834764831845f, rk = rsqrtf(sk + 1e-6f);
            bf16* o = QKVN + (size_t)row * 1536 + ch;
            *(unsigned*)o = pk2(q0 * rq, q1 * rq); *(unsigned*)(o + 512) = pk2(k0 * rk, k1 * rk); *(unsigned*)(o + 1024) = pk2(v0, v1);
            if (lane == 0) { const float bl = G8[(size_t)row * 8 + h], al = G8[(size_t)row * 8 + 4 + h] + dtb;
                const float sp = al > 15.f ? al : log1pf(__expf(al));
                GB[(size_t)row * 4 + h] = sigm(bl); GG[(size_t)row * 4 + h] = nA * sp; }
        }
    }
}
#if DN_NAIVE
__device__ __forceinline__ void dn_naive_phase(const bf16* QKVN, const float* GB, const float* GG, bf16* OL, int worker, int lane) {
    const int b = worker >> 7, h = (worker >> 5) & 3, eg = worker & 31;
    float S0[4] = {0.f, 0.f, 0.f, 0.f}, S1[4] = {0.f, 0.f, 0.f, 0.f};
    for (int t0 = 0; t0 < SEQ; t0 += 8) {
        unsigned kk[8], qq[8]; v2u vv[8]; float be[8], al[8];
#pragma unroll
        for (int i = 0; i < 8; ++i) { const size_t row = (size_t)b * SEQ + t0 + i; const bf16* p = QKVN + row * 1536 + h * 128;
            qq[i] = *(const unsigned*)(p + 2 * lane); kk[i] = *(const unsigned*)(p + 512 + 2 * lane); vv[i] = *(const v2u*)(p + 1024 + 4 * eg);
            be[i] = GB[row * 4 + h]; al[i] = GG[row * 4 + h]; }
#pragma unroll
        for (int i = 0; i < 8; ++i) {
            const float a = __expf(al[i]), k0 = bflo(kk[i]), k1 = bfhi(kk[i]), q0 = bflo(qq[i]), q1 = bfhi(qq[i]);
            const float v[4] = {bflo(vv[i].x), bfhi(vv[i].x), bflo(vv[i].y), bfhi(vv[i].y)};
            float ks[4], o[4];
#pragma unroll
            for (int e = 0; e < 4; ++e) { S0[e] *= a; S1[e] *= a; ks[e] = k0 * S0[e] + k1 * S1[e]; }
#pragma unroll
            for (int e = 0; e < 4; ++e) ks[e] = wave_sum(ks[e]);
#pragma unroll
            for (int e = 0; e < 4; ++e) { const float d = be[i] * (v[e] - ks[e]); S0[e] += k0 * d; S1[e] += k1 * d; o[e] = q0 * S0[e] + q1 * S1[e]; }
#pragma unroll
            for (int e = 0; e < 4; ++e) o[e] = wave_sum(o[e]);
            if (lane == 0) { v2u w; w.x = pk2(o[0], o[1]); w.y = pk2(o[2], o[3]); *(v2u*)(OL + ((size_t)b * SEQ + t0 + i) * 512 + h * 128 + 4 * eg) = w; }
        }
    }
}
#endif
__device__ __forceinline__ void dnnorm_phase(const bf16* OL, const bf16* Z, const float* on_g, bf16* YCAT, int gw, int NGW, int lane) {
    const f32x4 g0 = *(const f32x4*)(on_g + (8 * lane & 127)), g1 = *(const f32x4*)(on_g + (8 * lane & 127) + 4);
    for (int m = gw; m < M; m += NGW) {
        const v4u uo = *(const v4u*)(OL + (size_t)m * 512 + 8 * lane), uz = *(const v4u*)(Z + (size_t)m * 512 + 8 * lane);
        float o[8] = {bflo(uo.x), bfhi(uo.x), bflo(uo.y), bfhi(uo.y), bflo(uo.z), bfhi(uo.z), bflo(uo.w), bfhi(uo.w)};
        const float z[8] = {bflo(uz.x), bfhi(uz.x), bflo(uz.y), bfhi(uz.y), bflo(uz.z), bfhi(uz.z), bflo(uz.w), bfhi(uz.w)};
        float s = 0.f;
#pragma unroll
        for (int i = 0; i < 8; ++i) s += o[i] * o[i];
        s += __shfl_xor(s, 1); s += __shfl_xor(s, 2); s += __shfl_xor(s, 4); s += __shfl_xor(s, 8);
        const float r = rsqrtf(s * (1.f / 128.f) + 1e-6f);
        v4u w; w.x = pk2(o[0] * r * g0.x * z[0], o[1] * r * g0.y * z[1]); w.y = pk2(o[2] * r * g0.z * z[2], o[3] * r * g0.w * z[3]);
        w.z = pk2(o[4] * r * g1.x * z[4], o[5] * r * g1.y * z[5]); w.w = pk2(o[6] * r * g1.z * z[6], o[7] * r * g1.w * z[7]);
        *(v4u*)(YCAT + (size_t)m * D + 512 + 8 * lane) = w;
    }
}
__device__ __forceinline__ void ln_row(float* xrow, bf16* brow, const f32x4 (&gv)[4], const f32x4 (&bv)[4], int lane, f32x4 (&o)[4]) {
    f32x4* xr = (f32x4*)xrow + lane; f32x4 v[4]; float s = 0.f;
#pragma unroll
    for (int j = 0; j < 4; ++j) { v[j] = xr[64 * j]; s += (v[j].x + v[j].y) + (v[j].z + v[j].w); }
    const float mean = wave_sum(s) * (1.f / D); float s2 = 0.f;
#pragma unroll
    for (int j = 0; j < 4; ++j) { v[j] = v[j] - mean; s2 += (v[j].x * v[j].x + v[j].y * v[j].y) + (v[j].z * v[j].z + v[j].w * v[j].w); }
    const float rstd = rsqrtf(wave_sum(s2) * (1.f / D) + LN_EPS);
    v2u* o8 = (v2u*)brow + lane;
#pragma unroll
    for (int j = 0; j < 4; ++j) { o[j] = v[j] * rstd * gv[j] + bv[j]; xr[64 * j] = o[j]; v2u w; w.x = pk2(o[j].x, o[j].y); w.y = pk2(o[j].z, o[j].w); o8[64 * j] = w; }
}
__device__ __forceinline__ void ln_phase(float* X, bf16* XB, const float* g, const float* b, int gw, int NGW, int lane) {
    f32x4 gv[4], bv[4], o[4];
#pragma unroll
    for (int j = 0; j < 4; ++j) { gv[j] = ((const f32x4*)g)[lane + 64 * j]; bv[j] = ((const f32x4*)b)[lane + 64 * j]; }
    for (int m = gw; m < M; m += NGW) ln_row(X + (size_t)m * D, XB + (size_t)m * D, gv, bv, lane, o);
}
__device__ __forceinline__ void ln_router_phase(float* X, bf16* XB, const float* g, const float* b, const float* Wr, int4* RI, f32x2* RG, int* COUNTS, LAS unsigned char* lds, int wg, int tid, int wave, int lane) {
    LAS float* wl = (LAS float*)lds;
    LAS int* wcnt = (LAS int*)(lds + 32768);
    for (int i = tid; i < 2048; i += 512) ((LAS f32x4*)wl)[i] = ((const f32x4*)Wr)[i];
    __syncthreads();
    f32x4 gv[4], bv[4], o[4];
#pragma unroll
    for (int j = 0; j < 4; ++j) { gv[j] = ((const f32x4*)g)[lane + 64 * j]; bv[j] = ((const f32x4*)b)[lane + 64 * j]; }
    int c0 = 0, c1 = 0, c2 = 0, c3 = 0, c4 = 0, c5 = 0, c6 = 0, c7 = 0;
    int se1 = 0, se2 = 0, sr1 = 0, sr2 = 0; float sg1 = 0.f, sg2 = 0.f;
    const int rowb = wg * 128 + wave * 16;
    for (int i = 0; i < 16; ++i) {
        const int row = rowb + i;
        ln_row(X + (size_t)row * D, XB + (size_t)row * D, gv, bv, lane, o);
        float lgt[8] = {0.f, 0.f, 0.f, 0.f, 0.f, 0.f, 0.f, 0.f};
#pragma unroll
        for (int j = 0; j < 4; ++j)
#pragma unroll
            for (int c = 0; c < 4; ++c) { const int k = 256 * j + 4 * lane + c; const f32x4 wa = *(const LAS f32x4*)(wl + k * 8), wb = *(const LAS f32x4*)(wl + k * 8 + 4); const float xv = o[j][c];
                lgt[0] += xv * wa.x; lgt[1] += xv * wa.y; lgt[2] += xv * wa.z; lgt[3] += xv * wa.w; lgt[4] += xv * wb.x; lgt[5] += xv * wb.y; lgt[6] += xv * wb.z; lgt[7] += xv * wb.w; }
#pragma unroll
        for (int e = 0; e < 8; ++e) lgt[e] = wave_sum(lgt[e]);
        int i1 = 0; float v1 = lgt[0];
#pragma unroll
        for (int e = 1; e < 8; ++e) if (lgt[e] > v1) { v1 = lgt[e]; i1 = e; }
        int i2 = -1; float v2 = -3.0e38f;
#pragma unroll
        for (int e = 0; e < 8; ++e) if (e != i1 && lgt[e] > v2) { v2 = lgt[e]; i2 = e; }
        const float g1 = 1.0f / (1.0f + __expf(v2 - v1)), g2 = 1.0f - g1;
        int r1 = 0, r2 = 0;
#define RCNT(e, c) { r1 = (i1 == e) ? c : r1; r2 = (i2 == e) ? c : r2; c += (i1 == e) + (i2 == e); }
        RCNT(0, c0) RCNT(1, c1) RCNT(2, c2) RCNT(3, c3) RCNT(4, c4) RCNT(5, c5) RCNT(6, c6) RCNT(7, c7)
#undef RCNT
        if (lane == i) { se1 = i1; se2 = i2; sr1 = r1; sr2 = r2; sg1 = g1; sg2 = g2; }
    }
    if (lane < 8) { const int cv = lane == 0 ? c0 : lane == 1 ? c1 : lane == 2 ? c2 : lane == 3 ? c3 : lane == 4 ? c4 : lane == 5 ? c5 : lane == 6 ? c6 : c7; wcnt[wave * 8 + lane] = cv; }
    __syncthreads();
    if (lane < 16) { int o1 = 0, o2 = 0;
        for (int w = 0; w < wave; ++w) { o1 += wcnt[w * 8 + se1]; o2 += wcnt[w * 8 + se2]; }
        RI[rowb + lane] = make_int4(se1, se2, sr1 + o1, sr2 + o2); RG[rowb + lane] = (f32x2){sg1, sg2}; }
    if (tid < 8) { int s = 0;
#pragma unroll
        for (int w = 0; w < 8; ++w) s += wcnt[w * 8 + tid];
        COUNTS[wg * 8 + tid] = s; }
    __syncthreads();
}
__device__ __forceinline__ void moe_gather_phase(const bf16* XB, bf16* XG, const int4* RI, int2* POS, const int* COUNTS, int* META, LAS unsigned char* lds, int wg, int tid, int wave, int lane) {
    LAS int* tot = (LAS int*)lds; LAS int* pre = tot + 8; LAS int* segb = tot + 16;
    if (tid < 32) tot[tid] = 0;
    __syncthreads();
    if (tid < 256) {
#pragma unroll
        for (int e = 0; e < 8; ++e) { const int c = COUNTS[tid * 8 + e]; atomicAdd((int*)(tot + e), c); if (tid < wg) atomicAdd((int*)(pre + e), c); } }
    __syncthreads();
    if (tid == 0) { int s = 0; for (int e = 0; e < 8; ++e) { segb[e] = s; s += (tot[e] + 255) & ~255; } segb[8] = s;
        if (wg == 0) for (int e = 0; e < 9; ++e) META[e] = segb[e]; }
    __syncthreads();
    const int rowb = wg * 128 + wave * 16;
    for (int i = 0; i < 16; ++i) { const int row = rowb + i; const int4 ri = RI[row];
        const int p1 = segb[ri.x] + pre[ri.x] + ri.z, p2 = segb[ri.y] + pre[ri.y] + ri.w;
        if (lane == 0) POS[row] = make_int2(p1, p2);
        const v4u* s = (const v4u*)(XB + (size_t)row * D); const v4u a = s[lane], c = s[64 + lane];
        v4u* d1 = (v4u*)(XG + (size_t)p1 * D); v4u* d2 = (v4u*)(XG + (size_t)p2 * D);
        d1[lane] = a; d1[64 + lane] = c; d2[lane] = a; d2[64 + lane] = c; }
    __syncthreads();
}
__device__ __forceinline__ void moe_combine_phase(float* X, const bf16* Y, const int2* POS, const f32x2* RG, const float* g, const float* b, int gw, int NGW, int lane) {
    f32x4 gv[4], bv[4];
#pragma unroll
    for (int j = 0; j < 4; ++j) { gv[j] = ((const f32x4*)g)[lane + 64 * j]; bv[j] = ((const f32x4*)b)[lane + 64 * j]; }
    for (int m = gw; m < M; m += NGW) {
        const int2 pos = POS[m]; const f32x2 gg = RG[m];
        f32x4* xr = (f32x4*)(X + (size_t)m * D) + lane; const v2u* y1 = (const v2u*)(Y + (size_t)pos.x * D) + lane; const v2u* y2 = (const v2u*)(Y + (size_t)pos.y * D) + lane;
        f32x4 v[4]; float s = 0.f;
#pragma unroll
        for (int j = 0; j < 4; ++j) { const f32x4 xv = xr[64 * j]; const v2u a = y1[64 * j], c = y2[64 * j];
            v[j].x = ALPHA * xv.x + gg.x * bflo(a.x) + gg.y * bflo(c.x); v[j].y = ALPHA * xv.y + gg.x * bfhi(a.x) + gg.y * bfhi(c.x);
            v[j].z = ALPHA * xv.z + gg.x * bflo(a.y) + gg.y * bflo(c.y); v[j].w = ALPHA * xv.w + gg.x * bfhi(a.y) + gg.y * bfhi(c.y);
            s += (v[j].x + v[j].y) + (v[j].z + v[j].w); }
        const float mean = wave_sum(s) * (1.f / D); float s2 = 0.f;
#pragma unroll
        for (int j = 0; j < 4; ++j) { v[j] = v[j] - mean; s2 += (v[j].x * v[j].x + v[j].y * v[j].y) + (v[j].z * v[j].z + v[j].w * v[j].w); }
        const float rstd = rsqrtf(wave_sum(s2) * (1.f / D) + LN_EPS);
#pragma unroll
        for (int j = 0; j < 4; ++j) xr[64 * j] = v[j] * rstd * gv[j] + bv[j];
    }
}

#if !DN_NAIVE
constexpr int DP_QR = 0, DP_WT = 0, DP_KR = 18432, DP_VR = 36864, DP_UT = 36864, DP_VBT = 55296, DP_KBGT = 73728, DP_KDT = 92160, DP_AF = 110592, DP_TB = 110592, DP_ATT = 126976, DP_GS = 136192, DP_BS = 136448;
typedef unsigned short bf16s;
__device__ __forceinline__ bf16x8 lds_frag(const LAS unsigned char* p) { return *(const LAS bf16x8*)p; }
__device__ __forceinline__ v2u pack4(const f32x4 v) { v2u w; w.x = pk2(v[0], v[1]); w.y = pk2(v[2], v[3]); return w; }

__device__ __forceinline__ void dn_prep_phase(const bf16* QKVN, const float* GB, const float* GG, bf16* OL, bf16* QT, bf16* MC, LAS unsigned char* lds_, int item0, int istride, int tid_, int wave, int lane_) {
    for (int it = item0; it < (M / 64) * 4; it += istride) {
        int tid = tid_, lane = lane_; LAS unsigned char* lds = lds_;
        asm volatile("" : "+v"(tid), "+v"(lane), "+v"(lds));
        LAS float* Gs = (LAS float*)(lds + DP_GS); LAS float* Bs = (LAS float*)(lds + DP_BS);
        const int r = lane & 15, kq = lane >> 4;
        const int h = it & 3, row0 = (it >> 2) * 64;
        { const int t = tid >> 3, fb = tid & 7; const bf16* src = QKVN + (size_t)(row0 + t) * 1536 + h * 128 + 16 * fb;
          const v4u q0 = *(const v4u*)src, q1 = *(const v4u*)(src + 8), k0 = *(const v4u*)(src + 512), k1 = *(const v4u*)(src + 520), v0 = *(const v4u*)(src + 1024), v1 = *(const v4u*)(src + 1032);
          LAS unsigned char* d = lds + t * 272 + 32 * fb;
          *(LAS v4u*)(d + DP_QR) = q0; *(LAS v4u*)(d + DP_QR + 16) = q1; *(LAS v4u*)(d + DP_KR) = k0; *(LAS v4u*)(d + DP_KR + 16) = k1; *(LAS v4u*)(d + DP_VR) = v0; *(LAS v4u*)(d + DP_VR + 16) = v1; }
        if (wave == 0) { float g = GG[(size_t)(row0 + lane) * 4 + h]; const float be = GB[(size_t)(row0 + lane) * 4 + h];
#pragma unroll
            for (int o = 1; o < 64; o <<= 1) { const float up = __shfl_up(g, o); if (lane >= o) g += up; }
            Gs[lane] = g; Bs[lane] = be; }
        v2u qe[4];
#pragma unroll
        for (int ti = 0; ti < 4; ++ti) qe[ti] = *(const v2u*)(QKVN + (size_t)(row0 + 16 * ti + r) * 1536 + h * 128 + 16 * wave + 4 * kq);
        __syncthreads();
        { const int ti = wave >> 1, tj0 = (wave & 1) * 2;
          f32x4 kk[2] = {{0.f, 0.f, 0.f, 0.f}, {0.f, 0.f, 0.f, 0.f}}, qk[2] = {{0.f, 0.f, 0.f, 0.f}, {0.f, 0.f, 0.f, 0.f}};
#pragma unroll
          for (int s = 0; s < 4; ++s) { const int ko = 64 * s + 16 * kq; const bf16x8 ak = lds_frag(lds + DP_KR + (16 * ti + r) * 272 + ko), aq = lds_frag(lds + DP_QR + (16 * ti + r) * 272 + ko);
#pragma unroll
              for (int jj = 0; jj < 2; ++jj) { const bf16x8 bk = lds_frag(lds + DP_KR + (16 * (tj0 + jj) + r) * 272 + ko);
                  kk[jj] = __builtin_amdgcn_mfma_f32_16x16x32_bf16(ak, bk, kk[jj], 0, 0, 0); qk[jj] = __builtin_amdgcn_mfma_f32_16x16x32_bf16(aq, bk, qk[jj], 0, 0, 0); } }
#pragma unroll
          for (int jj = 0; jj < 2; ++jj) { const int j = 16 * (tj0 + jj) + r; const float Gj = Gs[j];
#pragma unroll
              for (int ii = 0; ii < 4; ++ii) { const int i = 16 * ti + 4 * kq + ii; const float dec = __expf(fminf(Gs[i] - Gj, 0.f));
                  ((LAS float*)(lds + DP_AF))[i * 64 + j] = (j < i) ? Bs[i] * kk[jj][ii] * dec : 0.f;
                  ((LAS bf16s*)(lds + DP_ATT))[i * 72 + j] = (bf16s)((j <= i) ? f2bf(qk[jj][ii] * dec) : 0u); } } }
        __syncthreads();
        if (wave == 0) {
            float tc[64]; const float lanef = (float)lane;
#pragma unroll
            for (int i = 0; i < 64; ++i) { float a0 = fmaxf(1.f - fabsf(lanef - (float)i), 0.f), a1 = 0.f;
#pragma unroll
                for (int j4 = 0; j4 < (i + 3) / 4; ++j4) { const f32x4 a = *(const LAS f32x4*)(lds + DP_AF + (i * 64 + 4 * j4) * 4);
#pragma unroll
                    for (int jj = 0; jj < 4; ++jj) { const int j = 4 * j4 + jj; if (j < i) { if (jj & 1) a1 -= a[jj] * tc[j]; else a0 -= a[jj] * tc[j]; } } }
                tc[i] = a0 + a1; }
            LDS_WAIT();
#pragma unroll
            for (int i = 0; i < 64; ++i) ((LAS bf16s*)(lds + DP_TB))[i * 72 + lane] = (bf16s)f2bf(tc[i]);
        } else {
            const float Gl = Gs[63];
            for (int idx = (wave - 1) * 64 + lane; idx < 1536; idx += 448) { const int x = idx >> 9, e = idx & 127, tq = (idx >> 7) & 3;
                const LAS unsigned char* src = lds + (x == 0 ? DP_VR : DP_KR) + (16 * tq) * 272 + 2 * e; unsigned pk[8];
#pragma unroll
                for (int tt = 0; tt < 16; tt += 2) { const int t0 = 16 * tq + tt;
                    const float g0 = Gs[t0], g1 = Gs[t0 + 1], b0 = Bs[t0], b1 = Bs[t0 + 1];
                    const float s0 = x == 0 ? b0 : (x == 1 ? b0 * __expf(g0) : __expf(Gl - g0)), s1 = x == 0 ? b1 : (x == 1 ? b1 * __expf(g1) : __expf(Gl - g1));
                    const float a0 = bflo((unsigned)*(const LAS bf16s*)(src + tt * 272)), a1 = bflo((unsigned)*(const LAS bf16s*)(src + (tt + 1) * 272));
                    pk[tt >> 1] = pk2(a0 * s0, a1 * s1); }
                LAS unsigned char* dst = lds + (x == 0 ? DP_VBT : (x == 1 ? DP_KBGT : DP_KDT)) + e * 144 + 32 * tq;
                *(LAS v4u*)dst = (v4u){pk[0], pk[1], pk[2], pk[3]}; *(LAS v4u*)(dst + 16) = (v4u){pk[4], pk[5], pk[6], pk[7]}; }
        }
        __syncthreads();
        { bf16x8 tf[4][2];
#pragma unroll
          for (int ti = 0; ti < 4; ++ti)
#pragma unroll
              for (int s = 0; s < 2; ++s) tf[ti][s] = lds_frag(lds + DP_TB + (16 * ti + r) * 144 + 64 * s + 16 * kq);
          bf16x8 vb[2], kb[2];
#pragma unroll
          for (int s = 0; s < 2; ++s) { vb[s] = lds_frag(lds + DP_VBT + (16 * wave + r) * 144 + 64 * s + 16 * kq); kb[s] = lds_frag(lds + DP_KBGT + (16 * wave + r) * 144 + 64 * s + 16 * kq); }
#pragma unroll
          for (int ti = 0; ti < 4; ++ti) { f32x4 au = {0.f, 0.f, 0.f, 0.f}, aw = {0.f, 0.f, 0.f, 0.f};
#pragma unroll
              for (int s = 0; s < 2; ++s) { au = __builtin_amdgcn_mfma_f32_16x16x32_bf16(tf[ti][s], vb[s], au, 0, 0, 0); aw = __builtin_amdgcn_mfma_f32_16x16x32_bf16(tf[ti][s], kb[s], aw, 0, 0, 0); }
              const int off = (16 * wave + r) * 144 + 2 * (16 * ti + 4 * kq);
              *(LAS v2u*)(lds + DP_UT + off) = pack4(au); *(LAS v2u*)(lds + DP_WT + off) = pack4(aw); } }
        __syncthreads();
        bf16x8 ua[2], wa[2];
#pragma unroll
        for (int s = 0; s < 2; ++s) { ua[s] = lds_frag(lds + DP_UT + (16 * wave + r) * 144 + 64 * s + 16 * kq); wa[s] = lds_frag(lds + DP_WT + (16 * wave + r) * 144 + 64 * s + 16 * kq); }
#pragma unroll
        for (int ti = 0; ti < 4; ++ti) { f32x4 ao = {0.f, 0.f, 0.f, 0.f}, aa = {0.f, 0.f, 0.f, 0.f};
#pragma unroll
            for (int s = 0; s < 2; ++s) { const bf16x8 at = lds_frag(lds + DP_ATT + (16 * ti + r) * 144 + 64 * s + 16 * kq);
                ao = __builtin_amdgcn_mfma_f32_16x16x32_bf16(ua[s], at, ao, 0, 0, 0); aa = __builtin_amdgcn_mfma_f32_16x16x32_bf16(wa[s], at, aa, 0, 0, 0); }
            const int i = 16 * ti + r; const float eg = __expf(Gs[i]); const size_t go = (size_t)(row0 + i) * 512 + h * 128 + 16 * wave + 4 * kq;
            *(v2u*)(OL + go) = pack4(ao);
            f32x4 qt; qt[0] = bflo(qe[ti].x) * eg - aa[0]; qt[1] = bfhi(qe[ti].x) * eg - aa[1]; qt[2] = bflo(qe[ti].y) * eg - aa[2]; qt[3] = bfhi(qe[ti].y) * eg - aa[3];
            *(v2u*)(QT + go) = pack4(qt); }
        { const float egl = __expf(Gs[63]); bf16* Mg = MC + (size_t)it * 32768; bf16* Cg = Mg + 16384;
          bf16x8 kda[2];
#pragma unroll
          for (int s = 0; s < 2; ++s) kda[s] = lds_frag(lds + DP_KDT + (16 * wave + r) * 144 + 64 * s + 16 * kq);
#pragma unroll
          for (int td = 0; td < 8; ++td) { f32x4 am = {0.f, 0.f, 0.f, 0.f}, ac = {0.f, 0.f, 0.f, 0.f};
#pragma unroll
              for (int s = 0; s < 2; ++s) { const bf16x8 kdb = lds_frag(lds + DP_KDT + (16 * td + r) * 144 + 64 * s + 16 * kq), ub = lds_frag(lds + DP_UT + (16 * td + r) * 144 + 64 * s + 16 * kq);
                  am = __builtin_amdgcn_mfma_f32_16x16x32_bf16(wa[s], kdb, am, 0, 0, 0);
                  ac = __builtin_amdgcn_mfma_f32_16x16x32_bf16(kda[s], ub, ac, 0, 0, 0); }
              const int d = 16 * td + r; f32x4 mm;
#pragma unroll
              for (int ii = 0; ii < 4; ++ii) { const int dp = 16 * wave + 4 * kq + ii; mm[ii] = ((d == dp) ? egl : 0.f) - am[ii]; }
              *(v2u*)(Mg + (size_t)d * 128 + 16 * wave + 4 * kq) = pack4(mm);
              *(v2u*)(Cg + (size_t)(16 * td + r) * 128 + 16 * wave + 4 * kq) = pack4(ac); } }
        __syncthreads();
    }
}
__device__ __forceinline__ void dn_scan_phase(const bf16* MC, const bf16* QT, bf16* OL, LAS unsigned char* lds, int bx, int wave, int lane) {
    const int r = lane & 15, kq = lane >> 4, bh = bx & 7, b = bh >> 2, h = bh & 3, e0 = 16 * (bx >> 3);
    for (int i = threadIdx.x; i < 2 * 16 * 272 / 4; i += NWAVES * 64) ((LAS unsigned*)lds)[i] = 0u;
    __syncthreads();
    const bool ow = wave < 4;
    bf16x8 ma[4], qb[4]; v2u cc, ol;
#define DN_LOAD(n) do { const size_t itx = ((size_t)(b * 256 + (n)) * 4 + h); const bf16* Mg = MC + itx * 32768; \
        _Pragma("unroll") for (int s = 0; s < 4; ++s) ma[s] = *(const bf16x8*)(Mg + (16 * wave + r) * 128 + 32 * s + 8 * kq); \
        cc = *(const v2u*)(Mg + 16384 + (e0 + r) * 128 + 16 * wave + 4 * kq); \
        if (ow) { const size_t go = ((size_t)b * SEQ + (n) * 64 + 16 * wave + r) * 512 + h * 128; \
            _Pragma("unroll") for (int s = 0; s < 4; ++s) qb[s] = *(const bf16x8*)(QT + go + 32 * s + 8 * kq); \
            ol = *(const v2u*)(OL + go + e0 + 4 * kq); } } while (0)
    DN_LOAD(0);
    for (int n = 0; n < 256; ++n) {
        bf16x8 mc[4], qc[4]; v2u ccc = cc, olc = ol;
#pragma unroll
        for (int s = 0; s < 4; ++s) { mc[s] = ma[s]; qc[s] = qb[s]; }
        if (n + 1 < 256) DN_LOAD(n + 1);
        const LAS unsigned char* stc = lds + (n & 1) * (16 * 272); LAS unsigned char* stn = lds + ((n + 1) & 1) * (16 * 272);
        bf16x8 sb[4];
#pragma unroll
        for (int s = 0; s < 4; ++s) sb[s] = lds_frag(stc + r * 272 + 64 * s + 16 * kq);
        f32x4 as = {bflo(ccc.x), bfhi(ccc.x), bflo(ccc.y), bfhi(ccc.y)};
#pragma unroll
        for (int s = 0; s < 4; ++s) as = __builtin_amdgcn_mfma_f32_16x16x32_bf16(mc[s], sb[s], as, 0, 0, 0);
        *(LAS v2u*)(stn + r * 272 + 2 * (16 * wave + 4 * kq)) = pack4(as);
        if (ow) { f32x4 ao = {bflo(olc.x), bfhi(olc.x), bflo(olc.y), bfhi(olc.y)};
#pragma unroll
            for (int s = 0; s < 4; ++s) ao = __builtin_amdgcn_mfma_f32_16x16x32_bf16(sb[s], qc[s], ao, 0, 0, 0);
            *(v2u*)(OL + ((size_t)b * SEQ + n * 64 + 16 * wave + r) * 512 + h * 128 + e0 + 4 * kq) = pack4(ao); }
        __syncthreads();
    }
#undef DN_LOAD
}
#endif
struct Args { const float* in[22]; float* out; unsigned char* ws; int ph, one, pad0, pad1; };
struct Ctx { int tid, lane, wave, G, bx, vcu, gw, NGW; };
#define RUN() (one || p == args.ph)
#define SEAM() do { if (one) xcd_barrier(bar); ++p; } while (0)
#define SKIP() do { ++p; } while (0)
#define WSP(T, off) ((T*)(ws + (off)))

template <int L> __device__ __forceinline__ void layer_mixer(const Args& args, LAS unsigned char* lds, const XcdBarrier& bar, const bool one, int& p, const Ctx& C) {
    unsigned char* ws = args.ws;
    if (RUN()) {
        pg8::Gemm g{WSP(const bf16, WS_XB), WSP(const bf16, WS_WIN) + (size_t)L * NIN * 1024, M, NIN, D}; pg8::StaticOrder S; S.init(M, NIN, C.G, C.bx);
        pg8::EpiInProj E{WSP(bf16, WS_GLU), WSP(bf16, WS_QKV), WSP(bf16, WS_Z)};
        pg8::gemm_phase<pg8::EpiInProj, pg8::StaticOrder, true, true>(lds, g, S, E);
        gates_phase(WSP(const bf16, WS_XB), WSP(const bf16, WS_WGT) + (size_t)L * 16 * 1024, WSP(float, WS_G8), C.gw, C.NGW, C.lane);
    }
    SEAM();
    if (RUN()) {
        conv_phase(WSP(const bf16, WS_GLU), WSP(bf16, WS_YCAT), args.in[2] + (size_t)L * 31 * 512, args.in[3] + L * 512, args.in[4] + L * 512, args.in[5] + L * 512, lds, C.vcu, C.G, C.wave, C.lane);
        dnpre_phase(WSP(const bf16, WS_QKV), WSP(bf16, WS_QKVN), WSP(const float, WS_G8), WSP(float, WS_GB), WSP(float, WS_GG), args.in[6] + (size_t)L * 4 * 1536, args.in[7] + L * 4, args.in[8] + L * 4, C.gw, C.NGW, C.lane);
    }
    SEAM();
#if DN_NAIVE
    if (RUN()) { if (C.wave == 0 && C.vcu < 256) dn_naive_phase(WSP(const bf16, WS_QKVN), WSP(const float, WS_GB), WSP(const float, WS_GG), WSP(bf16, WS_OL), C.vcu, C.lane); }
    SEAM();
    SKIP();
#else
    if (RUN()) dn_prep_phase(WSP(const bf16, WS_QKVN), WSP(const float, WS_GB), WSP(const float, WS_GG), WSP(bf16, WS_OL), WSP(bf16, WS_QT), WSP(bf16, WS_MC), lds, C.vcu, C.G, C.tid, C.wave, C.lane);
    SEAM();
    if (RUN()) { if (C.bx < 64) dn_scan_phase(WSP(const bf16, WS_MC), WSP(const bf16, WS_QT), WSP(bf16, WS_OL), lds, C.bx, C.wave, C.lane); }
    SEAM();
#endif
    if (RUN()) dnnorm_phase(WSP(const bf16, WS_OL), WSP(const bf16, WS_Z), args.in[9] + L * 128, WSP(bf16, WS_YCAT), C.gw, C.NGW, C.lane);
    SEAM();
    if (RUN()) {
        pg8::Gemm g{WSP(const bf16, WS_YCAT), WSP(const bf16, WS_WOUT) + (size_t)L * 1024 * 1024, M, D, D}; pg8::StaticOrder S; S.init(M, D, C.G, C.bx);
        pg8::EpiResid E{L == 0 ? args.in[0] : (const float*)args.out, args.out, ALPHA};
        pg8::gemm_phase<pg8::EpiResid, pg8::StaticOrder, true, true>(lds, g, S, E);
    }
    SEAM();
}

__global__ void __launch_bounds__(NWAVES * 64, 2) fwd_kernel(Args args) {
    extern __shared__ __attribute__((aligned(16))) unsigned char lds_raw[];
    LAS unsigned char* lds = (LAS unsigned char*)lds_raw;
    volatile LAS unsigned* MISC = (volatile LAS unsigned*)(lds + MISC_OFF);
    Ctx C;
    C.tid = threadIdx.x; C.lane = C.tid & 63; C.wave = __builtin_amdgcn_readfirstlane(C.tid >> 6);
    C.G = gridDim.x; C.bx = blockIdx.x; C.vcu = (C.G % 8 == 0) ? (C.bx % 8) * (C.G / 8) + C.bx / 8 : C.bx;
    C.gw = C.vcu * NWAVES + C.wave; C.NGW = C.G * NWAVES;
    unsigned char* ws = args.ws;
    unsigned* ctl = (unsigned*)(ws + WS_CTL);
    for (int u = C.tid; u < (LDS_BYTES - LDSCTL_OFF) / 4; u += NWAVES * 64) ((LAS unsigned*)(lds + LDSCTL_OFF))[u] = 0u;
    __syncthreads();
    const bool one = args.one != 0;
    XcdBarrier bar; bar.bar = ctl + CW_BAR; bar.x = 0; bar.st = nullptr;
    if (one) bar = xcd_barrier_post(ctl + CW_BAR, MISC + 8);
    int p = 0;

    if (RUN()) prologue_phase(args.in[0], args.in[1], args.in[10], args.in[13], args.in[14], args.in[15], ws, lds, C.gw, C.NGW, C.wave, C.lane);
    SEAM();

    layer_mixer<0>(args, lds, bar, one, p, C);
    if (RUN()) ln_phase(args.out, WSP(bf16, WS_XB), args.in[11], args.in[12], C.gw, C.NGW, C.lane);
    SEAM();
    if (RUN()) {
        pg8::Gemm g{WSP(const bf16, WS_XB), WSP(const bf16, WS_WGU0), M, 2 * FF0, D}; pg8::StaticOrder S; S.init(M, 2 * FF0, C.G, C.bx);
        pg8::EpiSwiGLU E{WSP(bf16, WS_HID0), FF0};
        pg8::gemm_phase<pg8::EpiSwiGLU, pg8::StaticOrder, true, true>(lds, g, S, E);
    }
    SEAM();
    if (RUN()) {
        pg8::Gemm g{WSP(const bf16, WS_HID0), WSP(const bf16, WS_WD0), M, D, FF0}; pg8::StaticOrder S; S.init(M, D, C.G, C.bx);
        pg8::EpiResid E{(const float*)args.out, args.out, ALPHA};
        pg8::gemm_phase<pg8::EpiResid, pg8::StaticOrder, true, true>(lds, g, S, E);
    }
    SEAM();
    if (RUN()) ln_phase(args.out, WSP(bf16, WS_XB), args.in[20], args.in[21], C.gw, C.NGW, C.lane);
    SEAM();
    SKIP(); SKIP();

    layer_mixer<1>(args, lds, bar, one, p, C);
    if (RUN()) {
        ln_router_phase(args.out, WSP(bf16, WS_XB), args.in[11] + D, args.in[12] + D, args.in[16], WSP(int4, WS_RI), WSP(f32x2, WS_RG), WSP(int, WS_COUNTS), lds, C.vcu, C.tid, C.wave, C.lane);
        moe_convert_phase(args.in[17], args.in[18], args.in[19], ws, lds, C.gw, C.NGW, C.wave, C.lane);
    }
    SEAM();
    if (RUN()) moe_gather_phase(WSP(const bf16, WS_XB), WSP(bf16, WS_XG), WSP(const int4, WS_RI), WSP(int2, WS_POS), WSP(const int, WS_COUNTS), WSP(int, WS_META), lds, C.vcu, C.tid, C.wave, C.lane);
    SEAM();
    for (int c = 0; c < 5; ++c) {
        asm volatile("" : "+s"(ws));
        int* META = WSP(int, WS_META);
        int tb[9];
#pragma unroll
        for (int e = 0; e < 9; ++e) tb[e] = __builtin_amdgcn_readfirstlane(__hip_atomic_load(META + e, __ATOMIC_RELAXED, __HIP_MEMORY_SCOPE_AGENT)) >> 8;
        const int T = tb[8], t0 = 64 * c, nt = (T - t0) < 64 ? (T - t0) : 64;
        if (RUN() && nt > 0) {
            pg8::MoeOrder<0> S; S.nM = nt; S.nN = 28; S.nwg = nt * 28; S.G = C.G; S.c = C.bx; S.t0 = t0; S.tb1 = tb[1]; S.tb2 = tb[2]; S.tb3 = tb[3]; S.tb4 = tb[4]; S.tb5 = tb[5]; S.tb6 = tb[6]; S.tb7 = tb[7];
            pg8::Gemm g{WSP(const bf16, WS_XG), WSP(const bf16, WS_WMGU), 0, 0, D};
            pg8::EpiSwiGLU E{WSP(bf16, WS_HIDM), FFE};
            pg8::gemm_phase<pg8::EpiSwiGLU, pg8::MoeOrder<0>, true, true>(lds, g, S, E);
        }
        if (nt > 0) SEAM(); else SKIP();
        if (RUN() && nt > 0) {
            pg8::MoeOrder<1> S; S.nM = nt; S.nN = 4; S.nwg = nt * 4; S.G = C.G; S.c = C.bx; S.t0 = t0; S.tb1 = tb[1]; S.tb2 = tb[2]; S.tb3 = tb[3]; S.tb4 = tb[4]; S.tb5 = tb[5]; S.tb6 = tb[6]; S.tb7 = tb[7];
            pg8::Gemm g{WSP(const bf16, WS_HIDM), WSP(const bf16, WS_WMD), 0, 0, FFE};
            pg8::EpiBf16 E{WSP(bf16, WS_XG), D};
            pg8::gemm_phase<pg8::EpiBf16, pg8::MoeOrder<1>, true, true>(lds, g, S, E);
        }
        if (nt > 0) SEAM(); else SKIP();
    }
    if (RUN()) moe_combine_phase(args.out, WSP(const bf16, WS_XG), WSP(const int2, WS_POS), WSP(const f32x2, WS_RG), args.in[20] + D, args.in[21] + D, C.gw, C.NGW, C.lane);
}
#undef RUN
#undef SEAM
#undef SKIP

extern "C" void kernel_launch(void* const* d_in, const int* in_sizes, int n_in, void* d_out, int out_size, void* d_ws, size_t ws_size, hipStream_t stream) {
    static int grid = 0;
    if (grid == 0) {
        if (n_in != 22 || in_sizes[0] != M * D || out_size != M * D || ws_size < WS_END) { fprintf(stderr, "kernel_launch: unexpected shapes / workspace (n_in %d, ws %zu < %zu); nothing launched\n", n_in, ws_size, (size_t)WS_END); grid = -1; return; }
        int dev = 0, cus = 0;
        if (hipGetDevice(&dev) != hipSuccess || hipDeviceGetAttribute(&cus, hipDeviceAttributeMultiprocessorCount, dev) != hipSuccess) { grid = -1; return; }
        if (hipFuncSetAttribute((const void*)fwd_kernel, hipFuncAttributeMaxDynamicSharedMemorySize, LDS_BYTES) != hipSuccess) { fprintf(stderr, "kernel_launch: hipFuncSetAttribute failed\n"); grid = -1; return; }
        (void)hipGetLastError();
        if (cus != 256) { fprintf(stderr, "kernel_launch: built for 256 CUs, device has %d; nothing launched\n", cus); grid = -1; return; }
        grid = cus;
    }
    if (grid < 0) return;
    if (hipMemsetAsync((char*)d_ws + WS_CTL, 0, CTL_ZERO_BYTES, stream) != hipSuccess) return;
    Args a{};
    for (int i = 0; i < 22; ++i) a.in[i] = (const float*)d_in[i];
    a.out = (float*)d_out; a.ws = (unsigned char*)d_ws;
#if MK_N_LAUNCHES == 1
    a.ph = 0; a.one = 1;
    hipLaunchKernelGGL(fwd_kernel, dim3(grid), dim3(NWAVES * 64), LDS_BYTES, stream, a);
#else
    for (int ph = 0; ph < NPH; ++ph) { a.ph = ph; a.one = 0; hipLaunchKernelGGL(fwd_kernel, dim3(grid), dim3(NWAVES * 64), LDS_BYTES, stream, a); }
#endif
}
```

```cpp
#include <hip/hip_runtime.h>
#include <cstdio>
#include <cstdint>

#ifndef MK_N_LAUNCHES
#define MK_N_LAUNCHES 1
#endif
#ifndef DN_NAIVE
#define DN_NAIVE 0
#endif

namespace pg8 {
#define PG8_LAS __attribute__((address_space(3)))
typedef unsigned short bf16_t;
typedef short bf16x8 __attribute__((ext_vector_type(8)));
typedef float f32x4 __attribute__((ext_vector_type(4)));
typedef unsigned u32x4 __attribute__((ext_vector_type(4)));
constexpr int BM = 256, BK = 64, HALF = 128, HTB = HALF * BK * 2  , STAGE_BYTES = 8 * HTB, NXCD = 8, WGM = 8;

__host__ __device__ __forceinline__ int lds_byte(int r, int c) { const int st = (r >> 4) * 2 + (c >> 5), rr = r & 15, cc = c & 31, ob = rr * 64 + cc * 2; return st * 1024 + (ob ^ (((ob >> 9) & 1) << 5)); }
__host__ __device__ __forceinline__ void stage_rc(int b, int& R, int& C) { const int st = b / 1024, sb = b % 1024, swz = sb ^ (((sb >> 9) & 1) << 5); R = (st >> 1) * 16 + swz / 64; C = (st & 1) * 32 + (swz % 64) / 2; }
__host__ __device__ __forceinline__ int perm32(int rho) { const int n = rho >> 4, i = rho & 15; return 8 * (i >> 2) + 4 * n + (i & 3); }

__device__ __forceinline__ int lane_id() { int l; asm volatile("v_mbcnt_lo_u32_b32 %0, -1, 0\n\tv_mbcnt_hi_u32_b32 %0, -1, %0" : "=v"(l)); return l; }
struct Unit { int pm, pn, om, on; };
struct Gemm { const bf16_t* A; const bf16_t* Bt; int M, N, K; };

struct StaticOrder {
    int nM, nN, nwg, G, c;
    __device__ __forceinline__ void init(int M, int N, int G_, int c_) { nM = M / BM; nN = N / BM; nwg = nM * nN; G = G_; c = c_; }
    __device__ __forceinline__ bool next(int i, Unit& u) const {
        const long L = (long)i * G + c; if (L >= nwg) return false;
        int wgid = (int)L; { const int q = nwg / NXCD, r = nwg % NXCD, xcd = wgid % NXCD, off = wgid / NXCD; wgid = (xcd < r ? xcd * (q + 1) : r * (q + 1) + (xcd - r) * q) + off; }
        const int nig = WGM * nN, gid = wgid / nig, fm = gid * WGM, gsz = (nM - fm) < WGM ? (nM - fm) : WGM;
        u.pm = fm + ((wgid % nig) % gsz); u.pn = (wgid % nig) / gsz; u.om = u.pm; u.on = u.pn; return true;
    }
    __device__ __forceinline__ void a_ready(const Unit&) const {}
    __device__ __forceinline__ void done(const Unit&) const {}
};
template <int MODE> struct MoeOrder {
    int nM, nN, nwg, G, c, t0; int tb1, tb2, tb3, tb4, tb5, tb6, tb7;
    __device__ __forceinline__ bool next(int i, Unit& u) const {
        const long L = (long)i * G + c; if (L >= nwg) return false;
        int wgid = (int)L; { const int q = nwg / NXCD, r = nwg % NXCD, xcd = wgid % NXCD, off = wgid / NXCD; wgid = (xcd < r ? xcd * (q + 1) : r * (q + 1) + (xcd - r) * q) + off; }
        const int nig = WGM * nN, gid = wgid / nig, fm = gid * WGM, gsz = (nM - fm) < WGM ? (nM - fm) : WGM;
        const int lm = fm + ((wgid % nig) % gsz), ln = (wgid % nig) / gsz, tile = t0 + lm;
        const int e = (tile >= tb1) + (tile >= tb2) + (tile >= tb3) + (tile >= tb4) + (tile >= tb5) + (tile >= tb6) + (tile >= tb7);
        u.pn = e * nN + ln; u.on = ln;
        if (MODE == 0) { u.pm = tile; u.om = lm; } else { u.pm = lm; u.om = tile; }
        return true;
    }
    __device__ __forceinline__ void a_ready(const Unit&) const {}
    __device__ __forceinline__ void done(const Unit&) const {}
};

__device__ __forceinline__ unsigned cvt_pk_bf16(float lo, float hi) { unsigned r; asm volatile("v_cvt_pk_bf16_f32 %0, %1, %2" : "=v"(r) : "v"(lo), "v"(hi)); return r; }
__device__ __forceinline__ float sigmoid_f(float x) { return __builtin_amdgcn_rcpf(1.0f + __expf(-x)); }
__device__ __forceinline__ float silu_f(float x) { return x * sigmoid_f(x); }

struct EpiInProj {
    static constexpr bool PERM = true, AFTER_DRAIN = false;
    bf16_t* GLU; bf16_t* QKV; bf16_t* Z;
    __device__ __forceinline__ void operator()(const f32x4 (&acc)[2][2][4][2], const Unit& u, int wr, int wc, int fr, int fq) const {
        const int row0 = u.om * BM + wr * 64 + fr, cl = wc * 32 + 8 * fq;
        if (u.on < 4) {
#pragma unroll
            for (int ai = 0; ai < 2; ++ai)
#pragma unroll
                for (int m = 0; m < 4; ++m) { bf16_t* rowp = GLU + (size_t)(row0 + ai * HALF + m * 16) * 512 + u.on * 128 + cl;
                    const f32x4 v0 = acc[ai][0][m][0], v1 = acc[ai][0][m][1], g0 = acc[ai][1][m][0], g1 = acc[ai][1][m][1];
                    u32x4 w; w.x = cvt_pk_bf16(v0[0] * sigmoid_f(g0[0]), v0[1] * sigmoid_f(g0[1])); w.y = cvt_pk_bf16(v0[2] * sigmoid_f(g0[2]), v0[3] * sigmoid_f(g0[3]));
                    w.z = cvt_pk_bf16(v1[0] * sigmoid_f(g1[0]), v1[1] * sigmoid_f(g1[1])); w.w = cvt_pk_bf16(v1[2] * sigmoid_f(g1[2]), v1[3] * sigmoid_f(g1[3]));
                    *(u32x4*)rowp = w; }
        } else if (u.on < 10) {
#pragma unroll
            for (int ai = 0; ai < 2; ++ai)
#pragma unroll
                for (int m = 0; m < 4; ++m) { bf16_t* rowp = QKV + (size_t)(row0 + ai * HALF + m * 16) * 1536 + (u.on - 4) * 256 + cl;
#pragma unroll
                    for (int bj = 0; bj < 2; ++bj) { const f32x4 v0 = acc[ai][bj][m][0], v1 = acc[ai][bj][m][1];
                        u32x4 w; w.x = cvt_pk_bf16(v0[0], v0[1]); w.y = cvt_pk_bf16(v0[2], v0[3]); w.z = cvt_pk_bf16(v1[0], v1[1]); w.w = cvt_pk_bf16(v1[2], v1[3]);
                        *(u32x4*)(rowp + bj * HALF) = w; } }
        } else {
#pragma unroll
            for (int ai = 0; ai < 2; ++ai)
#pragma unroll
                for (int m = 0; m < 4; ++m) { bf16_t* rowp = Z + (size_t)(row0 + ai * HALF + m * 16) * 512 + (u.on - 10) * 256 + cl;
#pragma unroll
                    for (int bj = 0; bj < 2; ++bj) { const f32x4 v0 = acc[ai][bj][m][0], v1 = acc[ai][bj][m][1];
                        u32x4 w; w.x = cvt_pk_bf16(silu_f(v0[0]), silu_f(v0[1])); w.y = cvt_pk_bf16(silu_f(v0[2]), silu_f(v0[3])); w.z = cvt_pk_bf16(silu_f(v1[0]), silu_f(v1[1])); w.w = cvt_pk_bf16(silu_f(v1[2]), silu_f(v1[3]));
                        *(u32x4*)(rowp + bj * HALF) = w; } }
        }
    }
};
struct EpiSwiGLU {
    static constexpr bool PERM = true, AFTER_DRAIN = false;
    bf16_t* H; int ldh;
    __device__ __forceinline__ void operator()(const f32x4 (&acc)[2][2][4][2], const Unit& u, int wr, int wc, int fr, int fq) const {
        const int row0 = u.om * BM + wr * 64 + fr, cl = u.on * 128 + wc * 32 + 8 * fq;
#pragma unroll
        for (int ai = 0; ai < 2; ++ai)
#pragma unroll
            for (int m = 0; m < 4; ++m) { bf16_t* rowp = H + (size_t)(row0 + ai * HALF + m * 16) * ldh + cl;
                const f32x4 g0 = acc[ai][0][m][0], g1 = acc[ai][0][m][1], u0 = acc[ai][1][m][0], u1 = acc[ai][1][m][1];
                u32x4 w; w.x = cvt_pk_bf16(silu_f(g0[0]) * u0[0], silu_f(g0[1]) * u0[1]); w.y = cvt_pk_bf16(silu_f(g0[2]) * u0[2], silu_f(g0[3]) * u0[3]);
                w.z = cvt_pk_bf16(silu_f(g1[0]) * u1[0], silu_f(g1[1]) * u1[1]); w.w = cvt_pk_bf16(silu_f(g1[2]) * u1[2], silu_f(g1[3]) * u1[3]);
                *(u32x4*)rowp = w; }
    }
};
struct EpiBf16 {
    static constexpr bool PERM = true, AFTER_DRAIN = false;
    bf16_t* O; int ldc;
    __device__ __forceinline__ void operator()(const f32x4 (&acc)[2][2][4][2], const Unit& u, int wr, int wc, int fr, int fq) const {
        const int row0 = u.om * BM + wr * 64 + fr, cl = u.on * BM + wc * 32 + 8 * fq;
#pragma unroll
        for (int ai = 0; ai < 2; ++ai)
#pragma unroll
            for (int m = 0; m < 4; ++m) { bf16_t* rowp = O + (size_t)(row0 + ai * HALF + m * 16) * ldc + cl;
#pragma unroll
                for (int bj = 0; bj < 2; ++bj) { const f32x4 v0 = acc[ai][bj][m][0], v1 = acc[ai][bj][m][1];
                    u32x4 w; w.x = cvt_pk_bf16(v0[0], v0[1]); w.y = cvt_pk_bf16(v0[2], v0[3]); w.z = cvt_pk_bf16(v1[0], v1[1]); w.w = cvt_pk_bf16(v1[2], v1[3]);
                    *(u32x4*)(rowp + bj * HALF) = w; } }
    }
};
struct EpiResid {
    static constexpr bool PERM = false, AFTER_DRAIN = false;
    const float* res; float* out; float alpha;
    __device__ __forceinline__ void operator()(const f32x4 (&acc)[2][2][4][2], const Unit& u, int wr, int wc, int fr, int fq) const {
        const int row0 = u.om * BM + wr * 64 + fr, col0 = u.on * BM + wc * 32 + 4 * fq;
#pragma unroll
        for (int ai = 0; ai < 2; ++ai)
#pragma unroll
            for (int m = 0; m < 4; ++m) { const size_t off = (size_t)(row0 + ai * HALF + m * 16) * 1024 + col0;
#pragma unroll
                for (int bj = 0; bj < 2; ++bj)
#pragma unroll
                    for (int n = 0; n < 2; ++n) { const f32x4 r = *(const f32x4*)(res + off + bj * HALF + n * 16); *(f32x4*)(out + off + bj * HALF + n * 16) = r * alpha + acc[ai][bj][m][n]; }
                asm volatile("" ::: "memory"); }
    }
};

template <class Epi, class Sched, bool ALIGN_EPI = false, bool SP2 = false>
__device__ __forceinline__ void gemm_phase(PG8_LAS unsigned char* lds, const Gemm g, const Sched& S, const Epi& E, const int wid) {
    const int lane = lane_id(), tid = wid * 64 + lane, wr = wid >> 2, wc = wid & 3, fr = lane & 15, fq = lane >> 4;
    const int K = g.K, nt = K / BK;
    unsigned voffA[2], voffB[2];
#pragma unroll
    for (int i = 0; i < 2; ++i) { int R, C; stage_rc(tid * 16 + i * 8192, R, C); const int Rb = Epi::PERM ? ((R & ~31) + perm32(R & 31)) : R;
        voffA[i] = (unsigned)(R * K + C) * 2u; voffB[i] = (unsigned)(Rb * K + C) * 2u; }
    const size_t kstep = (size_t)(BK * 2);
    const size_t hstep = (size_t)HALF * K * 2;
    const size_t tstep = 2 * hstep;
    const unsigned ldsw = (unsigned)wid * 1024u;
    const int aoff = lds_byte(wr * 64 + fr, fq * 8), boff = lds_byte(wc * 32 + fr, fq * 8);
#define PG8_SA(b, h) (((b) * 2 + (h)) * HTB)
#define PG8_SB(b, h) ((4 + (b) * 2 + (h)) * HTB)
#define PG8_STAGE(bufoff, gbase, voff) do { _Pragma("unroll") for (int _i = 0; _i < 2; ++_i) \
        __builtin_amdgcn_global_load_lds((const unsigned*)((const char*)(gbase) + (voff)[_i]), (PG8_LAS unsigned*)(lds + (bufoff) + ldsw + _i * 8192), 16, 0, 0); } while (0)
#define PG8_LDA(dst, b, h) do { _Pragma("unroll") for (int m = 0; m < 4; ++m) _Pragma("unroll") for (int k = 0; k < 2; ++k) dst[m][k] = *(const PG8_LAS bf16x8*)(lds + PG8_SA(b, h) + aoff + m * 2048 + k * 1024); } while (0)
#define PG8_LDB(dst, b, h) do { _Pragma("unroll") for (int n = 0; n < 2; ++n) _Pragma("unroll") for (int k = 0; k < 2; ++k) dst[n][k] = *(const PG8_LAS bf16x8*)(lds + PG8_SB(b, h) + boff + n * 2048 + k * 1024); } while (0)
#define PG8_MMA(ai, bj, At, Bt) do { __builtin_amdgcn_s_setprio(1); _Pragma("unroll") for (int m = 0; m < 4; ++m) _Pragma("unroll") for (int n = 0; n < 2; ++n) _Pragma("unroll") for (int k = 0; k < 2; ++k) \
        acc[ai][bj][m][n] = __builtin_amdgcn_mfma_f32_16x16x32_bf16(Bt[n][k], At[m][k], acc[ai][bj][m][n], 0, 0, 0); __builtin_amdgcn_s_setprio(0); } while (0)
#define PG8_WAIT_V(n) asm volatile("s_waitcnt vmcnt(" #n ")" ::: "memory")
#define PG8_WAIT_L(n) asm volatile("s_waitcnt lgkmcnt(" #n ")" ::: "memory")
#define PG8_BAR __builtin_amdgcn_s_barrier()
#define PG8_SCHED __builtin_amdgcn_sched_barrier(0)
    Unit cur, nxt; int ui = 0;
    if (!S.next(0, cur)) return;
    f32x4 acc[2][2][4][2];
#pragma unroll
    for (int a = 0; a < 2; ++a)
#pragma unroll
        for (int b = 0; b < 2; ++b)
#pragma unroll
            for (int m = 0; m < 4; ++m)
#pragma unroll
                for (int n = 0; n < 2; ++n) acc[a][b][m][n] = (f32x4){0.f, 0.f, 0.f, 0.f};
    bf16x8 At[4][2], B0[2][2], B1[2][2];
    const char* cA = (const char*)g.A + (size_t)cur.pm * tstep; const char* cB = (const char*)g.Bt + (size_t)cur.pn * tstep;
    S.a_ready(cur);
    if constexpr (SP2) {
        PG8_STAGE(PG8_SB(0, 0), cB, voffB); PG8_STAGE(PG8_SB(0, 1), cB + hstep, voffB); PG8_STAGE(PG8_SA(0, 0), cA, voffA); PG8_STAGE(PG8_SA(0, 1), cA + hstep, voffA);
        if (wr == 1) PG8_BAR;
        PG8_WAIT_V(2); PG8_BAR;
        PG8_STAGE(PG8_SB(1, 0), cB + kstep, voffB); PG8_STAGE(PG8_SA(1, 0), cA + kstep, voffA); PG8_STAGE(PG8_SB(1, 1), cB + hstep + kstep, voffB);
        PG8_WAIT_V(6); PG8_BAR;
    } else {
        PG8_STAGE(PG8_SB(0, 0), cB, voffB); PG8_STAGE(PG8_SA(0, 0), cA, voffA); PG8_STAGE(PG8_SB(0, 1), cB + hstep, voffB); PG8_STAGE(PG8_SA(0, 1), cA + hstep, voffA);
        if (wr == 1) PG8_BAR;
        PG8_WAIT_V(4); PG8_BAR;
        PG8_STAGE(PG8_SB(1, 0), cB + kstep, voffB); PG8_STAGE(PG8_SA(1, 0), cA + kstep, voffA); PG8_STAGE(PG8_SB(1, 1), cB + hstep + kstep, voffB);
        PG8_WAIT_V(6); PG8_BAR;
    }
    for (;;) {
        const bool has_next = S.next(ui + 1, nxt);
        const char* nA = has_next ? (const char*)g.A + (size_t)nxt.pm * tstep : cA; const char* nB = has_next ? (const char*)g.Bt + (size_t)nxt.pn * tstep : cB;
        for (int t = 0; t < nt; t += 2) {
            const bool last = (t == nt - 2);
            const char* a1 = cA + (size_t)(t + 1) * kstep;
            const char* a2 = last ? nA : cA + (size_t)(t + 2) * kstep; const char* b2 = last ? nB : cB + (size_t)(t + 2) * kstep;
            const char* a3 = a2 + kstep; const char* b3 = b2 + kstep;
            if (last && has_next) S.a_ready(nxt);
            if constexpr (SP2) {
            PG8_LDB(B0, 0, 0); PG8_LDB(B1, 0, 1); PG8_SCHED; PG8_LDA(At, 0, 0); PG8_STAGE(PG8_SA(1, 1), a1 + hstep, voffA);
            PG8_WAIT_V(8); PG8_WAIT_L(0); PG8_BAR; PG8_MMA(0, 0, At, B0); PG8_MMA(0, 1, At, B1); PG8_BAR; PG8_SCHED;
            PG8_LDA(At, 0, 1); PG8_STAGE(PG8_SB(0, 0), b2, voffB); PG8_STAGE(PG8_SB(0, 1), b2 + hstep, voffB); PG8_STAGE(PG8_SA(0, 0), a2, voffA);
            PG8_WAIT_V(8); PG8_WAIT_L(0); PG8_BAR; PG8_MMA(1, 0, At, B0); PG8_MMA(1, 1, At, B1); PG8_BAR; PG8_SCHED;
            PG8_LDB(B0, 1, 0); PG8_LDB(B1, 1, 1); PG8_SCHED; PG8_LDA(At, 1, 0); PG8_STAGE(PG8_SA(0, 1), a2 + hstep, voffA);
            PG8_WAIT_V(8); PG8_WAIT_L(0); PG8_BAR; PG8_MMA(0, 0, At, B0); PG8_MMA(0, 1, At, B1); PG8_BAR; PG8_SCHED;
            PG8_LDA(At, 1, 1); PG8_STAGE(PG8_SB(1, 0), b3, voffB); PG8_STAGE(PG8_SB(1, 1), b3 + hstep, voffB); PG8_STAGE(PG8_SA(1, 0), a3, voffA);
            PG8_WAIT_V(8); PG8_WAIT_L(0); PG8_BAR; PG8_MMA(1, 0, At, B0); PG8_MMA(1, 1, At, B1); PG8_BAR; PG8_SCHED;
            } else {
            PG8_LDB(B0, 0, 0); PG8_SCHED; PG8_LDA(At, 0, 0); PG8_STAGE(PG8_SA(1, 1), a1 + hstep, voffA);
            PG8_WAIT_L(8); PG8_BAR; PG8_WAIT_L(0); PG8_MMA(0, 0, At, B0); PG8_BAR; PG8_SCHED;
            PG8_LDB(B1, 0, 1); PG8_STAGE(PG8_SB(0, 0), b2, voffB);
            PG8_BAR; PG8_WAIT_L(0); PG8_MMA(0, 1, At, B1); PG8_BAR;
            PG8_LDA(At, 0, 1); PG8_STAGE(PG8_SA(0, 0), a2, voffA);
            PG8_BAR; PG8_WAIT_L(0); PG8_MMA(1, 0, At, B0); PG8_BAR; PG8_SCHED;
            PG8_STAGE(PG8_SB(0, 1), b2 + hstep, voffB);
            PG8_WAIT_V(6); PG8_BAR; PG8_MMA(1, 1, At, B1); PG8_BAR;
            PG8_LDB(B0, 1, 0); PG8_SCHED; PG8_LDA(At, 1, 0); PG8_STAGE(PG8_SA(0, 1), a2 + hstep, voffA);
            PG8_WAIT_L(8); PG8_BAR; PG8_WAIT_L(0); PG8_MMA(0, 0, At, B0); PG8_BAR; PG8_SCHED;
            PG8_LDB(B1, 1, 1); PG8_STAGE(PG8_SB(1, 0), b3, voffB);
            PG8_BAR; PG8_WAIT_L(0); PG8_MMA(0, 1, At, B1); PG8_BAR;
            PG8_LDA(At, 1, 1); PG8_STAGE(PG8_SA(1, 0), a3, voffA);
            PG8_BAR; PG8_WAIT_L(0); PG8_MMA(1, 0, At, B0); PG8_BAR; PG8_SCHED;
            PG8_STAGE(PG8_SB(1, 1), b3 + hstep, voffB);
            PG8_WAIT_V(6); PG8_BAR; PG8_MMA(1, 1, At, B1); PG8_BAR;
            }
        }
        if constexpr (ALIGN_EPI) { if (wr == 0) PG8_BAR; }
        if constexpr (!Epi::AFTER_DRAIN) { E(acc, cur, wr, wc, fr, fq); S.done(cur); }
        if (!has_next) break;
#pragma unroll
        for (int a = 0; a < 2; ++a)
#pragma unroll
            for (int b = 0; b < 2; ++b)
#pragma unroll
                for (int m = 0; m < 4; ++m)
#pragma unroll
                    for (int n = 0; n < 2; ++n) acc[a][b][m][n] = (f32x4){0.f, 0.f, 0.f, 0.f};
        cur = nxt; cA = nA; cB = nB; ++ui;
        if constexpr (ALIGN_EPI) { if (wr == 1) PG8_BAR; }
    }
    PG8_WAIT_V(0);
    if constexpr (!ALIGN_EPI) { if (wr == 0) PG8_BAR; }
    PG8_BAR;
    if constexpr (Epi::AFTER_DRAIN) { E.fused(acc, cur, wr, wc, fr, fq, lds, wid, lane); S.done(cur); }
#undef PG8_SA
#undef PG8_SB
#undef PG8_STAGE
#undef PG8_LDA
#undef PG8_LDB
#undef PG8_MMA
#undef PG8_WAIT_V
#undef PG8_WAIT_L
#undef PG8_BAR
#undef PG8_SCHED
}
}

constexpr int NWAVES = 8;
constexpr int BATCH = 2, SEQ = 16384, D = 1024, M = BATCH * SEQ;
constexpr int NIN = 3072, IN_COLS = 3080, FF0 = 2816, NE = 8, FFE = 3584;
constexpr float LN_EPS = 1e-5f;
constexpr float ALPHA = 1.41421356237309515f;
constexpr int NPH = 33;
constexpr size_t MiB = 1u << 20;
constexpr size_t WS_CTL = 0, CTL_ZERO_BYTES = 1 * MiB;
constexpr size_t WS_WGT = 1 * MiB;
constexpr size_t WS_COUNTS = 1 * MiB + 65536;
constexpr size_t WS_META = WS_COUNTS + 8192;
constexpr size_t WS_G8 = 2 * MiB;
constexpr size_t WS_GB = 3 * MiB;
constexpr size_t WS_GG = 3 * MiB + 512 * 1024;
constexpr size_t WS_RI = 4 * MiB;
constexpr size_t WS_RG = 4 * MiB + 512 * 1024;
constexpr size_t WS_POS = 4 * MiB + 768 * 1024;
constexpr size_t WS_WIN = 6 * MiB;
constexpr size_t WS_WOUT = 18 * MiB;
constexpr size_t WS_WGU0 = 22 * MiB;
constexpr size_t WS_WD0 = 33 * MiB;
constexpr size_t WS_XB = 40 * MiB;
constexpr size_t WS_OL = 40 * MiB;
constexpr size_t WS_QT = 72 * MiB;
constexpr size_t WS_R = 104 * MiB;
constexpr size_t WS_GLU = WS_R, WS_Z = WS_R + 32 * MiB, WS_YCAT = WS_R + 64 * MiB, WS_QKV = WS_R + 128 * MiB;
constexpr size_t WS_MC = WS_R + 288 * MiB;
constexpr size_t WS_QKVN = WS_R + 288 * MiB;
constexpr size_t WS_MPC = WS_GLU, WS_SST = WS_GLU + 16 * MiB;
constexpr size_t WS_QT2 = WS_R + 224 * MiB, WS_OL2 = WS_R + 256 * MiB;
constexpr size_t WS_HID0 = WS_R;
constexpr size_t WS_WMGU = WS_R, WS_WMD = WS_R + 112 * MiB, WS_XG = WS_R + 168 * MiB, WS_HIDM = WS_R + 300 * MiB, WS_END = WS_R + 416 * MiB;
constexpr int XG_ROWS = 2 * M + NE * 256;
static_assert(WS_XG + (size_t)XG_ROWS * D * 2 <= WS_HIDM && WS_HIDM + (size_t)16384 * FFE * 2 <= WS_END, "ws map");
constexpr int CW_BAR = 4096;
constexpr int RING_BYTES = 131072, LDSCTL_OFF = 159744, MISC_OFF = LDSCTL_OFF + 320, LDS_BYTES = 163840;

#define LAS __attribute__((address_space(3)))
using pg8::lane_id;
typedef unsigned short bf16;
typedef unsigned v4u __attribute__((ext_vector_type(4)));
typedef unsigned v2u __attribute__((ext_vector_type(2)));
typedef float f32x4 __attribute__((ext_vector_type(4)));
typedef float f32x2 __attribute__((ext_vector_type(2)));
typedef short bf16x8 __attribute__((ext_vector_type(8)));
#define LDS_WAIT() asm volatile("s_waitcnt lgkmcnt(0)" ::: "memory")
__device__ __forceinline__ unsigned f2bf(float f) { unsigned u = __builtin_bit_cast(unsigned, f); return (u + 0x7fffu + ((u >> 16) & 1u)) >> 16; }
__device__ __forceinline__ unsigned pk2(float lo, float hi) { return f2bf(lo) | (f2bf(hi) << 16); }
__device__ __forceinline__ float bflo(unsigned u) { return __builtin_bit_cast(float, u << 16); }
__device__ __forceinline__ float bfhi(unsigned u) { return __builtin_bit_cast(float, u & 0xffff0000u); }
__device__ __forceinline__ float wave_sum(float v) {
#pragma unroll
    for (int o = 1; o < 64; o <<= 1) v += __shfl_xor(v, o);
    return v;
}
__device__ __forceinline__ float sigm(float x) { return 1.0f / (1.0f + __expf(-x)); }

#define XB_TMO      128
#define XB_XCNT(j)  (256  + 64 * (j))
#define XB_XSUB(j)  (1280 + 64 * (j))
#define XB_XGEN(j)  (2304 + 64 * (j))
#define XB_TOP      3328
#define XB_TOPGEN   3392
#define XCD_BAR_WORDS 3456
#define XB_SPIN_CAP (1u << 18)
__device__ __forceinline__ unsigned xb_ld(unsigned* p)              { return __hip_atomic_load(p, __ATOMIC_RELAXED, __HIP_MEMORY_SCOPE_AGENT); }
__device__ __forceinline__ unsigned xb_add(unsigned* p, unsigned v) { return __hip_atomic_fetch_add(p, v, __ATOMIC_RELAXED, __HIP_MEMORY_SCOPE_AGENT); }
__device__ __forceinline__ unsigned xb_xcc_id() { return (unsigned)__builtin_amdgcn_s_getreg((3 << 11) | 20) & 0xFu; }
#define XB_SPIN(cond, bar) do { unsigned _sp = 0; while (cond) { __builtin_amdgcn_s_sleep(1); \
    if ((++_sp & 255u) == 0u) { if (xb_ld(&(bar)[XB_TMO])) break; if (_sp > XB_SPIN_CAP) { atomicAdd(&(bar)[XB_TMO], 1u); break; } } } } while (0)
struct XcdBarrier { unsigned* bar; unsigned x; volatile LAS unsigned* st; };
__device__ __forceinline__ XcdBarrier xcd_barrier_post(unsigned* bar, volatile LAS unsigned* st) {
    XcdBarrier b; b.bar = bar; b.x = xb_xcc_id(); b.st = st;
    if (threadIdx.x == 0) (void)xb_add(&bar[XB_XCNT(b.x)], 1u);
    return b;
}
__device__ __forceinline__ void xcd_barrier_complete(unsigned* bar, unsigned x, unsigned& nloc, unsigned& nx) {
    const unsigned G = gridDim.x * gridDim.y * gridDim.z;
    unsigned sum, cnt, mine, sp = 0u;
    for (;;) {
        sum = 0u; cnt = 0u; mine = 0u;
#pragma unroll
        for (unsigned j = 0; j < 16; ++j) { const unsigned c = xb_ld(&bar[XB_XCNT(j)]); sum += c; cnt += (c > 0u) ? 1u : 0u; mine = (j == x) ? c : mine; }
        if (sum == G) break;
        __builtin_amdgcn_s_sleep(1);
        if ((++sp & 255u) == 0u) { if (xb_ld(&bar[XB_TMO])) break; if (sp > XB_SPIN_CAP) { atomicAdd(&bar[XB_TMO], 1u); break; } }
    }
    nloc = mine > 0u ? mine : 1u; nx = cnt > 0u ? cnt : 1u;
}
__device__ __forceinline__ void xcd_barrier(const XcdBarrier& b) {
    asm volatile("s_waitcnt vmcnt(0)" ::: "memory");
    __syncthreads();
    if (threadIdx.x == 0) {
        unsigned* bar = b.bar;
        __builtin_amdgcn_s_waitcnt(0);
        unsigned nloc = b.st[0], nx = b.st[1];
        if (nloc == 0u) { xcd_barrier_complete(bar, b.x, nloc, nx); b.st[0] = nloc; b.st[1] = nx; }
        const unsigned old = xb_add(&bar[XB_XSUB(b.x)], 1u);
        const unsigned gen = old / nloc;
        if (old + 1u == (gen + 1u) * nloc) {
            __builtin_amdgcn_fence(__ATOMIC_RELEASE, "agent");
            asm volatile("s_waitcnt vmcnt(0)" ::: "memory");
            const unsigned og = xb_add(&bar[XB_TOP], 1u);
            const unsigned tg = og / nx;
            if (og + 1u == (tg + 1u) * nx) xb_add(&bar[XB_TOPGEN], 1u);
            else XB_SPIN(xb_ld(&bar[XB_TOPGEN]) == tg, bar);
            __builtin_amdgcn_fence(__ATOMIC_ACQUIRE, "agent");
            xb_add(&bar[XB_XGEN(b.x)], 1u);
            asm volatile("s_waitcnt vmcnt(0)" ::: "memory");
        } else {
            XB_SPIN(xb_ld(&bar[XB_XGEN(b.x)]) == gen, bar);
            __builtin_amdgcn_fence(__ATOMIC_ACQUIRE, "agent");
            asm volatile("s_waitcnt vmcnt(0)" ::: "memory");
        }
    }
    __syncthreads();
}

__device__ __forceinline__ void transpose_item(const float* W, int ldw, bf16* WT, int Kd, int k0, int n0, int drow0, LAS float* scr, int lane) {
#pragma unroll 8
    for (int i = 0; i < 32; ++i) { const int kk = 2 * i + (lane >> 5); scr[kk * 33 + (lane & 31)] = W[(size_t)(k0 + kk) * ldw + n0 + (lane & 31)]; }
    LDS_WAIT();
    const int c = lane & 7;
#pragma unroll
    for (int j = 0; j < 4; ++j) { const int n = (lane >> 3) + 8 * j; const LAS float* s = scr + (8 * c) * 33 + n;
        v4u o; o.x = pk2(s[0 * 33], s[1 * 33]); o.y = pk2(s[2 * 33], s[3 * 33]); o.z = pk2(s[4 * 33], s[5 * 33]); o.w = pk2(s[6 * 33], s[7 * 33]);
        *(v4u*)(WT + (size_t)(drow0 + n) * Kd + k0 + 8 * c) = o; }
    LDS_WAIT();
}
__device__ __forceinline__ void convert_ffn_item(const float* Wg, const float* Wu, const float* Wd, int F, bf16* WGU, bf16* WD, int r, LAS float* scr, int lane) {
    const int per = 16 * (F / 32);
    const int which = r / per, blk = r % per;
    if (which < 2) { const int nblk = F / 32, kb = blk / nblk, nb = blk % nblk, n0 = 32 * nb;
        transpose_item(which ? Wu : Wg, F, WGU, 1024, 64 * kb, n0, 256 * (n0 >> 7) + (n0 & 127) + (which ? 128 : 0), scr, lane); }
    else { const int kb = blk / 32, nb = blk % 32; transpose_item(Wd, 1024, WD, F, 64 * kb, 32 * nb, 32 * nb, scr, lane); }
}

__device__ __forceinline__ void prologue_phase(const float* x, const float* w_in, const float* w_out, const float* fg, const float* fu, const float* fd, unsigned char* ws, LAS unsigned char* lds, int gw, int NGW, int wave, int lane) {
    LAS float* scr = (LAS float*)(lds + wave * 16384);
    for (int it = gw; it < 2 * 16 * 96; it += NGW) { const int l = it / 1536, r = it % 1536, kb = r / 96, nb = r % 96, n0 = 32 * nb;
        const int drow0 = n0 < 512 ? 256 * (n0 >> 7) + (n0 & 127) : (n0 < 1024 ? 256 * ((n0 - 512) >> 7) + 128 + (n0 & 127) : n0);
        transpose_item(w_in + (size_t)l * 1024 * IN_COLS, IN_COLS, (bf16*)(ws + WS_WIN) + (size_t)l * NIN * 1024, 1024, 64 * kb, n0, drow0, scr, lane); }
    for (int it = gw; it < 2 * 16 * 32; it += NGW) { const int l = it / 512, r = it % 512, kb = r / 32, nb = r % 32;
        transpose_item(w_out + (size_t)l * 1024 * 1024, 1024, (bf16*)(ws + WS_WOUT) + (size_t)l * 1024 * 1024, 1024, 64 * kb, 32 * nb, 32 * nb, scr, lane); }
    for (int it = gw; it < 3 * 16 * (FF0 / 32); it += NGW) convert_ffn_item(fg, fu, fd, FF0, (bf16*)(ws + WS_WGU0), (bf16*)(ws + WS_WD0), it, scr, lane);
    { bf16* WGT = (bf16*)(ws + WS_WGT); const int tid = gw * 64 + lane, nth = NGW * 64;
      for (int i = tid; i < 2 * 16 * 1024; i += nth) { const int l = i >> 14, j = (i >> 10) & 15, k = i & 1023; WGT[i] = (bf16)(j < 8 ? f2bf(w_in[(size_t)l * 1024 * IN_COLS + (size_t)k * IN_COLS + NIN + j]) : 0u); } }
    { const f32x4* xs = (const f32x4*)x; v4u* xb = (v4u*)(ws + WS_XB); const size_t tid = (size_t)gw * 64 + lane, nth = (size_t)NGW * 64;
      for (size_t i = tid; i < (size_t)M * D / 8; i += nth) { const f32x4 a = xs[2 * i], b = xs[2 * i + 1]; v4u o; o.x = pk2(a.x, a.y); o.y = pk2(a.z, a.w); o.z = pk2(b.x, b.y); o.w = pk2(b.z, b.w); xb[i] = o; } }
}
__device__ __forceinline__ void moe_convert_phase(const float* mg, const float* mu, const float* md, unsigned char* ws, LAS unsigned char* lds, int gw, int NGW, int wave, int lane) {
    LAS float* scr = (LAS float*)(lds + wave * 16384);
    constexpr int PER_E = 3 * 16 * (FFE / 32);
    for (int it = gw; it < NE * PER_E; it += NGW) { const int e = it / PER_E, r = it % PER_E;
        convert_ffn_item(mg + (size_t)e * 1024 * FFE, mu + (size_t)e * 1024 * FFE, md + (size_t)e * FFE * 1024, FFE, (bf16*)(ws + WS_WMGU) + (size_t)e * 2 * FFE * 1024, (bf16*)(ws + WS_WMD) + (size_t)e * 1024 * FFE, r, scr, lane); }
}
__device__ __forceinline__ void gates_phase(const bf16* XB, const bf16* WgT, float* G8, int gw, int NGW, int lane) {
    for (int tg = gw; tg < M / 16; tg += NGW) {
        const int t0 = tg * 16; f32x4 acc = {0.f, 0.f, 0.f, 0.f};
        const bf16* ap = XB + (size_t)(t0 + (lane & 15)) * D + 8 * (lane >> 4);
        const bf16* bp = WgT + (size_t)(lane & 15) * D + 8 * (lane >> 4);
#pragma unroll 8
        for (int s = 0; s < 32; ++s) { const bf16x8 a = *(const bf16x8*)(ap + 32 * s), b = *(const bf16x8*)(bp + 32 * s); acc = __builtin_amdgcn_mfma_f32_16x16x32_bf16(a, b, acc, 0, 0, 0); }
        if ((lane & 15) < 8) {
#pragma unroll
            for (int i = 0; i < 4; ++i) G8[(size_t)(t0 + 4 * (lane >> 4) + i) * 8 + (lane & 15)] = acc[i]; }
    }
}
__device__ __forceinline__ void conv_phase(const bf16* GLU, bf16* YCAT, const float* dw_w, const float* dw_b, const float* lg, const float* lb, LAS unsigned char* lds, int item0, int istride, int wave, int lane) {
    const int cg = wave & 3, th = wave >> 2, c0 = cg * 128 + 2 * lane;
    float w0[31], w1[31];
#pragma unroll
    for (int j = 0; j < 31; ++j) { const f32x2 w = *(const f32x2*)(dw_w + j * 512 + c0); w0[j] = w.x; w1[j] = w.y; }
    const f32x2 bias = *(const f32x2*)(dw_b + c0), gam = *(const f32x2*)(lg + c0), bet = *(const f32x2*)(lb + c0);
    LAS f32x2* part = (LAS f32x2*)lds;
    int buf = 0;
    for (int item = item0; item < M / 64; item += istride) {
        const int b = item >> 8, n = item & 255;
        for (int tb = 0; tb < 4; ++tb) {
            const int tl = n * 64 + th * 32 + tb * 8;
            unsigned in[38];
#pragma unroll
            for (int r = 0; r < 38; ++r) { const int t = tl - 30 + r; const unsigned v = *(const unsigned*)(GLU + (size_t)(b * SEQ + (t < 0 ? 0 : t)) * 512 + c0); in[r] = (t >= 0) ? v : 0u; }
            float a0[8], a1[8];
#pragma unroll
            for (int i = 0; i < 8; ++i) { a0[i] = bias.x; a1[i] = bias.y; }
#pragma unroll
            for (int r = 0; r < 38; ++r) { const float x0 = bflo(in[r]), x1 = bfhi(in[r]);
#pragma unroll
                for (int i = 0; i < 8; ++i) { const int j = r - i; if (j >= 0 && j <= 30) { a0[i] += w0[j] * x0; a1[i] += w1[j] * x1; } } }
#pragma unroll
            for (int i = 0; i < 8; ++i) { const float s = wave_sum(a0[i] + a1[i]), q = wave_sum(a0[i] * a0[i] + a1[i] * a1[i]);
                if (lane == 0) part[((buf * 2 + th) * 8 + i) * 4 + cg] = (f32x2){s, q}; }
            __syncthreads();
#pragma unroll
            for (int i = 0; i < 8; ++i) { const LAS f32x2* pp = part + ((buf * 2 + th) * 8 + i) * 4; const f32x2 p0 = pp[0], p1 = pp[1], p2 = pp[2], p3 = pp[3];
                const float mean = ((p0.x + p1.x) + (p2.x + p3.x)) * (1.f / 512.f), ex2 = ((p0.y + p1.y) + (p2.y + p3.y)) * (1.f / 512.f);
                const float rstd = rsqrtf(fmaxf(ex2 - mean * mean, 0.f) + LN_EPS);
                const float y0 = (a0[i] - mean) * rstd * gam.x + bet.x, y1 = (a1[i] - mean) * rstd * gam.y + bet.y;
                *(unsigned*)(YCAT + (size_t)(b * SEQ + tl + i) * D + c0) = pk2(y0 * sigm(y0), y1 * sigm(y1)); }
            buf ^= 1;
        }
    }
}
__device__ __forceinline__ void dnpre_phase(const bf16* QKV, bf16* QKVN, const float* G8, float* GB, float* GG, const float* scw, const float* a_log, const float* dt_bias, int gw, int NGW, int lane) {
    for (int it = gw; it < (M / 16) * 4; it += NGW) {
        const int h = it & 3, row0 = (it >> 2) * 16, tl0 = row0 & (SEQ - 1), ch = h * 128 + 2 * lane;
        f32x2 wq[4], wk[4], wv[4];
#pragma unroll
        for (int j = 0; j < 4; ++j) { wq[j] = *(const f32x2*)(scw + j * 1536 + ch); wk[j] = *(const f32x2*)(scw + j * 1536 + 512 + ch); wv[j] = *(const f32x2*)(scw + j * 1536 + 1024 + ch); }
        const float nA = -__expf(a_log[h]), dtb = dt_bias[h];
        for (int i = 0; i < 16; ++i) {
            const int row = row0 + i, tl = tl0 + i;
            float q0 = 0.f, q1 = 0.f, k0 = 0.f, k1 = 0.f, v0 = 0.f, v1 = 0.f;
#pragma unroll
            for (int j = 0; j < 4; ++j) { if (tl - 3 + j >= 0) { const bf16* p = QKV + (size_t)(row - 3 + j) * 1536 + ch;
                const unsigned uq = *(const unsigned*)p, uk = *(const unsigned*)(p + 512), uv = *(const unsigned*)(p + 1024);
                q0 += wq[j].x * bflo(uq); q1 += wq[j].y * bfhi(uq); k0 += wk[j].x * bflo(uk); k1 += wk[j].y * bfhi(uk); v0 += wv[j].x * bflo(uv); v1 += wv[j].y * bfhi(uv); } }
            q0 *= sigm(q0); q1 *= sigm(q1); k0 *= sigm(k0); k1 *= sigm(k1); v0 *= sigm(v0); v1 *= sigm(v1);
            const float sq = wave_sum(q0 * q0 + q1 * q1), sk = wave_sum(k0 * k0 + k1 * k1);
            const float rq = rsqrtf(sq + 1e-6f) * 0.08838834764831845f, rk = rsqrtf(sk + 1e-6f);
            bf16* o = QKVN + (size_t)row * 1536 + ch;
            *(unsigned*)o = pk2(q0 * rq, q1 * rq); *(unsigned*)(o + 512) = pk2(k0 * rk, k1 * rk); *(unsigned*)(o + 1024) = pk2(v0, v1);
            if (lane == 0) { const float bl = G8[(size_t)row * 8 + h], al = G8[(size_t)row * 8 + 4 + h] + dtb;
                const float sp = al > 15.f ? al : log1pf(__expf(al));
                GB[(size_t)row * 4 + h] = sigm(bl); GG[(size_t)row * 4 + h] = nA * sp; }
        }
    }
}
#if DN_NAIVE
__device__ __forceinline__ void dn_naive_phase(const bf16* QKVN, const float* GB, const float* GG, bf16* OL, int worker, int lane) {
    const int b = worker >> 7, h = (worker >> 5) & 3, eg = worker & 31;
    float S0[4] = {0.f, 0.f, 0.f, 0.f}, S1[4] = {0.f, 0.f, 0.f, 0.f};
    for (int t0 = 0; t0 < SEQ; t0 += 8) {
        unsigned kk[8], qq[8]; v2u vv[8]; float be[8], al[8];
#pragma unroll
        for (int i = 0; i < 8; ++i) { const size_t row = (size_t)b * SEQ + t0 + i; const bf16* p = QKVN + row * 1536 + h * 128;
            qq[i] = *(const unsigned*)(p + 2 * lane); kk[i] = *(const unsigned*)(p + 512 + 2 * lane); vv[i] = *(const v2u*)(p + 1024 + 4 * eg);
            be[i] = GB[row * 4 + h]; al[i] = GG[row * 4 + h]; }
#pragma unroll
        for (int i = 0; i < 8; ++i) {
            const float a = __expf(al[i]), k0 = bflo(kk[i]), k1 = bfhi(kk[i]), q0 = bflo(qq[i]), q1 = bfhi(qq[i]);
            const float v[4] = {bflo(vv[i].x), bfhi(vv[i].x), bflo(vv[i].y), bfhi(vv[i].y)};
            float ks[4], o[4];
#pragma unroll
            for (int e = 0; e < 4; ++e) { S0[e] *= a; S1[e] *= a; ks[e] = k0 * S0[e] + k1 * S1[e]; }
#pragma unroll
            for (int e = 0; e < 4; ++e) ks[e] = wave_sum(ks[e]);
#pragma unroll
            for (int e = 0; e < 4; ++e) { const float d = be[i] * (v[e] - ks[e]); S0[e] += k0 * d; S1[e] += k1 * d; o[e] = q0 * S0[e] + q1 * S1[e]; }
#pragma unroll
            for (int e = 0; e < 4; ++e) o[e] = wave_sum(o[e]);
            if (lane == 0) { v2u w; w.x = pk2(o[0], o[1]); w.y = pk2(o[2], o[3]); *(v2u*)(OL + ((size_t)b * SEQ + t0 + i) * 512 + h * 128 + 4 * eg) = w; }
        }
    }
}
#endif
__device__ __forceinline__ void dnnorm_phase(const bf16* OL, const bf16* Z, const float* on_g, bf16* YCAT, int gw, int NGW, int lane) {
    const f32x4 g0 = *(const f32x4*)(on_g + (8 * lane & 127)), g1 = *(const f32x4*)(on_g + (8 * lane & 127) + 4);
    for (int m = gw; m < M; m += NGW) {
        const v4u uo = *(const v4u*)(OL + (size_t)m * 512 + 8 * lane), uz = *(const v4u*)(Z + (size_t)m * 512 + 8 * lane);
        float o[8] = {bflo(uo.x), bfhi(uo.x), bflo(uo.y), bfhi(uo.y), bflo(uo.z), bfhi(uo.z), bflo(uo.w), bfhi(uo.w)};
        const float z[8] = {bflo(uz.x), bfhi(uz.x), bflo(uz.y), bfhi(uz.y), bflo(uz.z), bfhi(uz.z), bflo(uz.w), bfhi(uz.w)};
        float s = 0.f;
#pragma unroll
        for (int i = 0; i < 8; ++i) s += o[i] * o[i];
        s += __shfl_xor(s, 1); s += __shfl_xor(s, 2); s += __shfl_xor(s, 4); s += __shfl_xor(s, 8);
        const float r = rsqrtf(s * (1.f / 128.f) + 1e-6f);
        v4u w; w.x = pk2(o[0] * r * g0.x * z[0], o[1] * r * g0.y * z[1]); w.y = pk2(o[2] * r * g0.z * z[2], o[3] * r * g0.w * z[3]);
        w.z = pk2(o[4] * r * g1.x * z[4], o[5] * r * g1.y * z[5]); w.w = pk2(o[6] * r * g1.z * z[6], o[7] * r * g1.w * z[7]);
        *(v4u*)(YCAT + (size_t)m * D + 512 + 8 * lane) = w;
    }
}
__device__ __forceinline__ void ln_row(float* xrow, bf16* brow, const f32x4 (&gv)[4], const f32x4 (&bv)[4], int lane, f32x4 (&o)[4]) {
    f32x4* xr = (f32x4*)xrow + lane; f32x4 v[4]; float s = 0.f;
#pragma unroll
    for (int j = 0; j < 4; ++j) { v[j] = xr[64 * j]; s += (v[j].x + v[j].y) + (v[j].z + v[j].w); }
    const float mean = wave_sum(s) * (1.f / D); float s2 = 0.f;
#pragma unroll
    for (int j = 0; j < 4; ++j) { v[j] = v[j] - mean; s2 += (v[j].x * v[j].x + v[j].y * v[j].y) + (v[j].z * v[j].z + v[j].w * v[j].w); }
    const float rstd = rsqrtf(wave_sum(s2) * (1.f / D) + LN_EPS);
    v2u* o8 = (v2u*)brow + lane;
#pragma unroll
    for (int j = 0; j < 4; ++j) { o[j] = v[j] * rstd * gv[j] + bv[j]; xr[64 * j] = o[j]; v2u w; w.x = pk2(o[j].x, o[j].y); w.y = pk2(o[j].z, o[j].w); o8[64 * j] = w; }
}
__device__ __forceinline__ void ln_phase(float* X, bf16* XB, const float* g, const float* b, int gw, int NGW, int lane) {
    f32x4 gv[4], bv[4], o[4];
#pragma unroll
    for (int j = 0; j < 4; ++j) { gv[j] = ((const f32x4*)g)[lane + 64 * j]; bv[j] = ((const f32x4*)b)[lane + 64 * j]; }
    for (int m = gw; m < M; m += NGW) ln_row(X + (size_t)m * D, XB + (size_t)m * D, gv, bv, lane, o);
}
__device__ __forceinline__ void ln_router_phase(float* X, bf16* XB, const float* g, const float* b, const float* Wr, int4* RI, f32x2* RG, int* COUNTS, LAS unsigned char* lds, int wg, int tid, int wave, int lane) {
    LAS float* wl = (LAS float*)lds;
    LAS int* wcnt = (LAS int*)(lds + 32768);
    for (int i = tid; i < 2048; i += 512) ((LAS f32x4*)wl)[i] = ((const f32x4*)Wr)[i];
    __syncthreads();
    f32x4 gv[4], bv[4], o[4];
#pragma unroll
    for (int j = 0; j < 4; ++j) { gv[j] = ((const f32x4*)g)[lane + 64 * j]; bv[j] = ((const f32x4*)b)[lane + 64 * j]; }
    int c0 = 0, c1 = 0, c2 = 0, c3 = 0, c4 = 0, c5 = 0, c6 = 0, c7 = 0;
    int se1 = 0, se2 = 0, sr1 = 0, sr2 = 0; float sg1 = 0.f, sg2 = 0.f;
    const int rowb = wg * 128 + wave * 16;
    for (int i = 0; i < 16; ++i) {
        const int row = rowb + i;
        ln_row(X + (size_t)row * D, XB + (size_t)row * D, gv, bv, lane, o);
        float lgt[8] = {0.f, 0.f, 0.f, 0.f, 0.f, 0.f, 0.f, 0.f};
#pragma unroll
        for (int j = 0; j < 4; ++j)
#pragma unroll
            for (int c = 0; c < 4; ++c) { const int k = 256 * j + 4 * lane + c; const f32x4 wa = *(const LAS f32x4*)(wl + k * 8), wb = *(const LAS f32x4*)(wl + k * 8 + 4); const float xv = o[j][c];
                lgt[0] += xv * wa.x; lgt[1] += xv * wa.y; lgt[2] += xv * wa.z; lgt[3] += xv * wa.w; lgt[4] += xv * wb.x; lgt[5] += xv * wb.y; lgt[6] += xv * wb.z; lgt[7] += xv * wb.w; }
#pragma unroll
        for (int e = 0; e < 8; ++e) lgt[e] = wave_sum(lgt[e]);
        int i1 = 0; float v1 = lgt[0];
#pragma unroll
        for (int e = 1; e < 8; ++e) if (lgt[e] > v1) { v1 = lgt[e]; i1 = e; }
        int i2 = -1; float v2 = -3.0e38f;
#pragma unroll
        for (int e = 0; e < 8; ++e) if (e != i1 && lgt[e] > v2) { v2 = lgt[e]; i2 = e; }
        const float g1 = 1.0f / (1.0f + __expf(v2 - v1)), g2 = 1.0f - g1;
        int r1 = 0, r2 = 0;
#define RCNT(e, c) { r1 = (i1 == e) ? c : r1; r2 = (i2 == e) ? c : r2; c += (i1 == e) + (i2 == e); }
        RCNT(0, c0) RCNT(1, c1) RCNT(2, c2) RCNT(3, c3) RCNT(4, c4) RCNT(5, c5) RCNT(6, c6) RCNT(7, c7)
#undef RCNT
        if (lane == i) { se1 = i1; se2 = i2; sr1 = r1; sr2 = r2; sg1 = g1; sg2 = g2; }
    }
    if (lane < 8) { const int cv = lane == 0 ? c0 : lane == 1 ? c1 : lane == 2 ? c2 : lane == 3 ? c3 : lane == 4 ? c4 : lane == 5 ? c5 : lane == 6 ? c6 : c7; wcnt[wave * 8 + lane] = cv; }
    __syncthreads();
    if (lane < 16) { int o1 = 0, o2 = 0;
        for (int w = 0; w < wave; ++w) { o1 += wcnt[w * 8 + se1]; o2 += wcnt[w * 8 + se2]; }
        RI[rowb + lane] = make_int4(se1, se2, sr1 + o1, sr2 + o2); RG[rowb + lane] = (f32x2){sg1, sg2}; }
    if (tid < 8) { int s = 0;
#pragma unroll
        for (int w = 0; w < 8; ++w) s += wcnt[w * 8 + tid];
        COUNTS[wg * 8 + tid] = s; }
    __syncthreads();
}
__device__ __forceinline__ void moe_gather_phase(const bf16* XB, bf16* XG, const int4* RI, int2* POS, const int* COUNTS, int* META, LAS unsigned char* lds, int wg, int tid, int wave, int lane) {
    LAS int* tot = (LAS int*)lds; LAS int* pre = tot + 8; LAS int* segb = tot + 16;
    if (tid < 32) tot[tid] = 0;
    __syncthreads();
    if (tid < 256) {
#pragma unroll
        for (int e = 0; e < 8; ++e) { const int c = COUNTS[tid * 8 + e]; atomicAdd((int*)(tot + e), c); if (tid < wg) atomicAdd((int*)(pre + e), c); } }
    __syncthreads();
    if (tid == 0) { int s = 0; for (int e = 0; e < 8; ++e) { segb[e] = s; s += (tot[e] + 255) & ~255; } segb[8] = s;
        if (wg == 0) for (int e = 0; e < 9; ++e) META[e] = segb[e]; }
    __syncthreads();
    const int rowb = wg * 128 + wave * 16;
    for (int i = 0; i < 16; ++i) { const int row = rowb + i; const int4 ri = RI[row];
        const int p1 = segb[ri.x] + pre[ri.x] + ri.z, p2 = segb[ri.y] + pre[ri.y] + ri.w;
        if (lane == 0) POS[row] = make_int2(p1, p2);
        const v4u* s = (const v4u*)(XB + (size_t)row * D); const v4u a = s[lane], c = s[64 + lane];
        v4u* d1 = (v4u*)(XG + (size_t)p1 * D); v4u* d2 = (v4u*)(XG + (size_t)p2 * D);
        d1[lane] = a; d1[64 + lane] = c; d2[lane] = a; d2[64 + lane] = c; }
    __syncthreads();
}
__device__ __forceinline__ void moe_combine_phase(float* X, const bf16* Y, const int2* POS, const f32x2* RG, const float* g, const float* b, int gw, int NGW, int lane) {
    f32x4 gv[4], bv[4];
#pragma unroll
    for (int j = 0; j < 4; ++j) { gv[j] = ((const f32x4*)g)[lane + 64 * j]; bv[j] = ((const f32x4*)b)[lane + 64 * j]; }
    for (int m = gw; m < M; m += NGW) {
        const int2 pos = POS[m]; const f32x2 gg = RG[m];
        f32x4* xr = (f32x4*)(X + (size_t)m * D) + lane; const v2u* y1 = (const v2u*)(Y + (size_t)pos.x * D) + lane; const v2u* y2 = (const v2u*)(Y + (size_t)pos.y * D) + lane;
        f32x4 v[4]; float s = 0.f;
#pragma unroll
        for (int j = 0; j < 4; ++j) { const f32x4 xv = xr[64 * j]; const v2u a = y1[64 * j], c = y2[64 * j];
            v[j].x = ALPHA * xv.x + gg.x * bflo(a.x) + gg.y * bflo(c.x); v[j].y = ALPHA * xv.y + gg.x * bfhi(a.x) + gg.y * bfhi(c.x);
            v[j].z = ALPHA * xv.z + gg.x * bflo(a.y) + gg.y * bflo(c.y); v[j].w = ALPHA * xv.w + gg.x * bfhi(a.y) + gg.y * bfhi(c.y);
            s += (v[j].x + v[j].y) + (v[j].z + v[j].w); }
        const float mean = wave_sum(s) * (1.f / D); float s2 = 0.f;
#pragma unroll
        for (int j = 0; j < 4; ++j) { v[j] = v[j] - mean; s2 += (v[j].x * v[j].x + v[j].y * v[j].y) + (v[j].z * v[j].z + v[j].w * v[j].w); }
        const float rstd = rsqrtf(wave_sum(s2) * (1.f / D) + LN_EPS);
#pragma unroll
        for (int j = 0; j < 4; ++j) xr[64 * j] = v[j] * rstd * gv[j] + bv[j];
    }
}

#if !DN_NAIVE
constexpr int DP_QR = 0, DP_KR = 18432, DP_WT = 18432, DP_VR = 36864, DP_UT = 36864, DP_VBT = 55296, DP_KBGT = 73728, DP_KDT = 92160, DP_AF = 110592, DP_TB = 110592, DP_ATT = 126976,
              DP_GS = 136192, DP_BS = 136448, DP_TLT = 136704, DP_THR = DP_TLT + 2560, DP_XT = DP_THR + 2560, DP_TR1 = DP_XT + 2560, DP_TT2 = DP_TR1 + 1280, DP_CW = DP_TT2 + 1280, DP_AFT = DP_CW + 6144;
typedef unsigned short bf16s;
#define BAR_L() do { asm volatile("s_waitcnt lgkmcnt(0)" ::: "memory"); __builtin_amdgcn_s_barrier(); asm volatile("" ::: "memory"); } while (0)
__device__ __forceinline__ bf16x8 lds_frag(const LAS unsigned char* p) { return *(const LAS bf16x8*)p; }
__device__ __forceinline__ v2u pack4(const f32x4 v) { v2u w; w.x = pk2(v[0], v[1]); w.y = pk2(v[2], v[3]); return w; }
__device__ __forceinline__ void unpack8(const v4u u, float (&f)[8]) { f[0] = bflo(u.x); f[1] = bfhi(u.x); f[2] = bflo(u.y); f[3] = bfhi(u.y); f[4] = bflo(u.z); f[5] = bfhi(u.z); f[6] = bflo(u.w); f[7] = bfhi(u.w); }
struct PpPf { v4u q0, q1, k0, k1, v0, v1, halo; float bl, al; };

#define PP_STAGE() asm volatile("" : "+v"(lane), "+v"(lds)); const int r = lane & 15, kq = lane >> 4, tid = wave * 64 + lane, tt = tid >> 3, fb = tid & 7; (void)r; (void)kq; (void)tt; (void)fb; \
        LAS float* Gs = (LAS float*)(lds + DP_GS); LAS float* Bs = (LAS float*)(lds + DP_BS); (void)Gs; (void)Bs
__device__ __forceinline__ void dn_prep_phase(const bf16* QKV, const float* G8, const float* scw, const float* a_log, const float* dt_bias, bf16* OL, bf16* QT, bf16* MC, LAS unsigned char* lds_, int item0, int istride, int tid_, int wave, int lane_) {
    constexpr int NIT = (M / 64) * 4;
    if (item0 >= NIT) return;
    const int h = item0 & 3;
    { LAS float* cw = (LAS float*)(lds_ + DP_CW);
      for (int i = tid_; i < 1536; i += NWAVES * 64) { const int j = i / 384, rem = i % 384, x = rem >> 7, c = rem & 127; cw[i] = scw[j * 1536 + x * 512 + h * 128 + c]; } }
    const float nA = -__expf(a_log[h]), dtb = dt_bias[h];
#define PP_LOAD(P, it_) do { const int row0_ = ((it_) >> 2) * 64, tl0_ = row0_ & (SEQ - 1); const bf16* s_ = QKV + (size_t)(row0_ + tt) * 1536 + h * 128 + 16 * fb; \
        P.q0 = *(const v4u*)s_; P.q1 = *(const v4u*)(s_ + 8); P.k0 = *(const v4u*)(s_ + 512); P.k1 = *(const v4u*)(s_ + 520); P.v0 = *(const v4u*)(s_ + 1024); P.v1 = *(const v4u*)(s_ + 1032); \
        P.halo = (v4u){0u, 0u, 0u, 0u}; \
        if (tid < 144) { const int hr_ = tid / 48, rem_ = tid % 48, x_ = rem_ >> 4, c16_ = rem_ & 15; if (tl0_ - 3 + hr_ >= 0) P.halo = *(const v4u*)(QKV + (size_t)(row0_ - 3 + hr_) * 1536 + x_ * 512 + h * 128 + 8 * c16_); } \
        if (wave == 0) { P.bl = G8[(size_t)(row0_ + lane) * 8 + h]; P.al = G8[(size_t)(row0_ + lane) * 8 + 4 + h]; } } while (0)
    PpPf pf;
    { const int lane = lane_, tid = tid_, tt = tid >> 3, fb = tid & 7; pf.bl = 0.f; pf.al = 0.f; PP_LOAD(pf, item0); }
    for (int it = item0; it < NIT; it += istride) {
        int lane = lane_; LAS unsigned char* lds = lds_;
        const int row0 = (it >> 2) * 64;
        PpPf cur = pf;
        { PP_STAGE(); LAS unsigned char* dq = lds + DP_VBT + (tt + 3) * 272 + 32 * fb;
          *(LAS v4u*)dq = cur.q0; *(LAS v4u*)(dq + 16) = cur.q1; *(LAS v4u*)(dq + 18432) = cur.k0; *(LAS v4u*)(dq + 18432 + 16) = cur.k1; *(LAS v4u*)(dq + 36864) = cur.v0; *(LAS v4u*)(dq + 36864 + 16) = cur.v1;
          if (tid < 144) { const int hr = tid / 48, rem = tid % 48, x = rem >> 4, c16 = rem & 15; *(LAS v4u*)(lds + DP_VBT + x * 18432 + hr * 272 + 16 * c16) = cur.halo; } }
        BAR_L();
        { PP_STAGE(); const LAS float* cw = (const LAS float*)(lds + DP_CW);
#pragma unroll 1
          for (int x = 0; x < 3; ++x) { float acc[16];
#pragma unroll
              for (int c = 0; c < 16; ++c) acc[c] = 0.f;
#pragma unroll
              for (int j = 0; j < 4; ++j) { const LAS unsigned char* rp = lds + DP_VBT + x * 18432 + (tt + j) * 272 + 32 * fb; float xv[8], yv[8];
                  unpack8(*(const LAS v4u*)rp, xv); unpack8(*(const LAS v4u*)(rp + 16), yv);
                  const LAS f32x4* wp = (const LAS f32x4*)(cw + (j * 3 + x) * 128 + 16 * fb); const f32x4 w0 = wp[0], w1 = wp[1], w2 = wp[2], w3 = wp[3];
#pragma unroll
                  for (int c = 0; c < 4; ++c) { acc[c] += w0[c] * xv[c]; acc[4 + c] += w1[c] * xv[4 + c]; acc[8 + c] += w2[c] * yv[c]; acc[12 + c] += w3[c] * yv[4 + c]; } }
              float sq = 0.f;
#pragma unroll
              for (int c = 0; c < 16; ++c) { acc[c] *= sigm(acc[c]); sq += acc[c] * acc[c]; }
              float sc = 1.f;
              if (x < 2) { sq += __shfl_xor(sq, 1); sq += __shfl_xor(sq, 2); sq += __shfl_xor(sq, 4); sc = rsqrtf(sq + 1e-6f) * (x == 0 ? 0.08838834764831845f : 1.f); }
              LAS unsigned char* dp = lds + x * 18432 + tt * 272 + 32 * fb;
              *(LAS v4u*)dp = (v4u){pk2(acc[0] * sc, acc[1] * sc), pk2(acc[2] * sc, acc[3] * sc), pk2(acc[4] * sc, acc[5] * sc), pk2(acc[6] * sc, acc[7] * sc)};
              *(LAS v4u*)(dp + 16) = (v4u){pk2(acc[8] * sc, acc[9] * sc), pk2(acc[10] * sc, acc[11] * sc), pk2(acc[12] * sc, acc[13] * sc), pk2(acc[14] * sc, acc[15] * sc)}; } }
        if (wave == 0) { PP_STAGE(); const float alx = cur.al + dtb; float g = nA * (alx > 15.f ? alx : log1pf(__expf(alx))); const float be = sigm(cur.bl);
#pragma unroll
            for (int o = 1; o < 64; o <<= 1) { const float up = __shfl_up(g, o); if (lane >= o) g += up; }
            Gs[lane] = g; Bs[lane] = be; }
        BAR_L();
        { PP_STAGE(); const int ti = wave >> 1, tj0 = (wave & 1) * 2;
          f32x4 kk[2] = {{0.f, 0.f, 0.f, 0.f}, {0.f, 0.f, 0.f, 0.f}}, qk[2] = {{0.f, 0.f, 0.f, 0.f}, {0.f, 0.f, 0.f, 0.f}};
#pragma unroll
          for (int s = 0; s < 4; ++s) { const int ko = 64 * s + 16 * kq; const bf16x8 ak = lds_frag(lds + DP_KR + (16 * ti + r) * 272 + ko), aq = lds_frag(lds + DP_QR + (16 * ti + r) * 272 + ko);
#pragma unroll
              for (int jj = 0; jj < 2; ++jj) { const bf16x8 bk = lds_frag(lds + DP_KR + (16 * (tj0 + jj) + r) * 272 + ko);
                  kk[jj] = __builtin_amdgcn_mfma_f32_16x16x32_bf16(ak, bk, kk[jj], 0, 0, 0); qk[jj] = __builtin_amdgcn_mfma_f32_16x16x32_bf16(aq, bk, qk[jj], 0, 0, 0); } }
#pragma unroll
          for (int jj = 0; jj < 2; ++jj) { const int j = 16 * (tj0 + jj) + r; const float Gj = Gs[j];
#pragma unroll
              for (int ii = 0; ii < 4; ++ii) { const int i = 16 * ti + 4 * kq + ii; const float dec = __expf(fminf(Gs[i] - Gj, 0.f));
                  const float av = (j < i) ? Bs[i] * kk[jj][ii] * dec : 0.f;
                  ((LAS float*)(lds + DP_AF))[i * 64 + j] = av;
                  if (ti == tj0 + jj) ((LAS float*)(lds + DP_AFT))[(ti * 16 + (j & 15)) * 16 + (i & 15)] = av;
                  ((LAS bf16s*)(lds + DP_ATT))[i * 72 + j] = (bf16s)((j <= i) ? f2bf(qk[jj][ii] * dec) : 0u); } } }
        BAR_L();
        if (wave == 0) { PP_STAGE();
            const int p = lane >> 4, c = lane & 15; const LAS float* at = (const LAS float*)(lds + DP_AFT) + p * 256;
            float tc[16]; f32x4 cb[2][4];
#pragma unroll
            for (int i = 0; i < 16; ++i) tc[i] = (c == i) ? 1.f : 0.f;
#pragma unroll
            for (int q4 = 0; q4 < 4; ++q4) cb[0][q4] = *(const LAS f32x4*)(at + 4 * q4);
#pragma unroll
            for (int j = 0; j < 15; ++j) { const int pp = j & 1;
                if (j + 1 < 15) {
#pragma unroll
                    for (int q4 = (j + 2) / 4; q4 < 4; ++q4) cb[pp ^ 1][q4] = *(const LAS f32x4*)(at + (j + 1) * 16 + 4 * q4); }
                const float tj = tc[j];
#pragma unroll
                for (int i = j + 1; i < 16; ++i) tc[i] -= cb[pp][i >> 2][i & 3] * tj;
                asm volatile("" ::: "memory");
            }
            const LAS float* af = (const LAS float*)(lds + DP_AF);
            bf16x8 a10, a32, al[2]; const bf16x8 zf = {0, 0, 0, 0, 0, 0, 0, 0};
            { const int kk2 = kq & 1; const f32x4 x0 = *(const LAS f32x4*)(af + (16 + r) * 64 + 8 * kk2), x1 = *(const LAS f32x4*)(af + (16 + r) * 64 + 8 * kk2 + 4);
              const f32x4 y0 = *(const LAS f32x4*)(af + (48 + r) * 64 + 32 + 8 * kk2), y1 = *(const LAS f32x4*)(af + (48 + r) * 64 + 32 + 8 * kk2 + 4);
              const v4u px = {pk2(x0[0], x0[1]), pk2(x0[2], x0[3]), pk2(x1[0], x1[1]), pk2(x1[2], x1[3])}, py = {pk2(y0[0], y0[1]), pk2(y0[2], y0[3]), pk2(y1[0], y1[1]), pk2(y1[2], y1[3])};
              a10 = kq < 2 ? __builtin_bit_cast(bf16x8, px) : zf; a32 = kq < 2 ? __builtin_bit_cast(bf16x8, py) : zf; }
#pragma unroll
            for (int tm = 0; tm < 2; ++tm) { const LAS float* ap = af + (32 + 16 * tm + r) * 64 + 8 * kq; const f32x4 x0 = *(const LAS f32x4*)ap, x1 = *(const LAS f32x4*)(ap + 4);
                const v4u pkd = {pk2(x0[0], x0[1]), pk2(x0[2], x0[3]), pk2(x1[0], x1[1]), pk2(x1[2], x1[3])}; al[tm] = __builtin_bit_cast(bf16x8, pkd); }
            LDS_WAIT();
            { LAS bf16s* TB = (LAS bf16s*)(lds + DP_TB); LAS bf16s* TLT = (LAS bf16s*)(lds + DP_TLT); LAS bf16s* THR = (LAS bf16s*)(lds + DP_THR); LAS bf16s* TR1 = (LAS bf16s*)(lds + DP_TR1); LAS bf16s* TT2 = (LAS bf16s*)(lds + DP_TT2);
              { const v4u z = {0u, 0u, 0u, 0u};
                if (lane < 32) { *(LAS v4u*)(TB + lane * 72 + 32) = z; *(LAS v4u*)(TB + lane * 72 + 40) = z; *(LAS v4u*)(TB + lane * 72 + 48) = z; *(LAS v4u*)(TB + lane * 72 + 56) = z; }
                if (lane < 16) { *(LAS v4u*)(TB + lane * 72 + 16) = z; *(LAS v4u*)(TB + lane * 72 + 24) = z; *(LAS v4u*)(TB + (32 + lane) * 72 + 48) = z; *(LAS v4u*)(TB + (32 + lane) * 72 + 56) = z;
                                 *(LAS v4u*)(TLT + (16 + lane) * 40) = z; *(LAS v4u*)(TLT + (16 + lane) * 40 + 8) = z; *(LAS v4u*)(THR + lane * 40 + 16) = z; *(LAS v4u*)(THR + lane * 40 + 24) = z; } }
              v4u tk[2];
              tk[0] = (v4u){pk2(tc[0], tc[1]), pk2(tc[2], tc[3]), pk2(tc[4], tc[5]), pk2(tc[6], tc[7])}; tk[1] = (v4u){pk2(tc[8], tc[9]), pk2(tc[10], tc[11]), pk2(tc[12], tc[13]), pk2(tc[14], tc[15])};
              if (p == 0) { *(LAS v4u*)(TLT + c * 40) = tk[0]; *(LAS v4u*)(TLT + c * 40 + 8) = tk[1]; }
              if (p == 1) { *(LAS v4u*)(TLT + (16 + c) * 40 + 16) = tk[0]; *(LAS v4u*)(TLT + (16 + c) * 40 + 24) = tk[1]; }
              if (p == 2) { *(LAS v4u*)(TT2 + c * 40) = tk[0]; *(LAS v4u*)(TT2 + c * 40 + 8) = tk[1]; }
#pragma unroll
              for (int i = 0; i < 16; ++i) { const bf16s tv = (bf16s)f2bf(tc[i]);
                  TB[(16 * p + i) * 72 + 16 * p + c] = tv;
                  if (p == 1) TR1[i * 40 + c] = tv;
                  if (p == 2) THR[i * 40 + c] = tv;
                  if (p == 3) THR[(16 + i) * 40 + 16 + c] = tv; } }
            LDS_WAIT();
            { const bf16x8 b0 = kq < 2 ? lds_frag(lds + DP_TLT + r * 80 + 16 * (kq & 1)) : zf, b2 = kq < 2 ? lds_frag(lds + DP_TT2 + r * 80 + 16 * (kq & 1)) : zf;
              const f32x4 x10 = __builtin_amdgcn_mfma_f32_16x16x32_bf16(a10, b0, (f32x4){0.f, 0.f, 0.f, 0.f}, 0, 0, 0), x32 = __builtin_amdgcn_mfma_f32_16x16x32_bf16(a32, b2, (f32x4){0.f, 0.f, 0.f, 0.f}, 0, 0, 0);
              *(LAS v2u*)(lds + DP_XT + r * 80 + 8 * kq) = pack4(x10); *(LAS v2u*)(lds + DP_XT + 1280 + r * 80 + 8 * kq) = pack4(x32); }
            LDS_WAIT();
            { const bf16x8 a11 = kq < 2 ? lds_frag(lds + DP_TR1 + r * 80 + 16 * (kq & 1)) : zf, a33 = kq < 2 ? lds_frag(lds + DP_THR + (16 + r) * 80 + 32 + 16 * (kq & 1)) : zf;
              const bf16x8 bx = kq < 2 ? lds_frag(lds + DP_XT + r * 80 + 16 * (kq & 1)) : zf, by = kq < 2 ? lds_frag(lds + DP_XT + 1280 + r * 80 + 16 * (kq & 1)) : zf;
              const f32x4 t10 = __builtin_amdgcn_mfma_f32_16x16x32_bf16(a11, bx, (f32x4){0.f, 0.f, 0.f, 0.f}, 0, 0, 0), t32 = __builtin_amdgcn_mfma_f32_16x16x32_bf16(a33, by, (f32x4){0.f, 0.f, 0.f, 0.f}, 0, 0, 0);
              LAS bf16s* TB = (LAS bf16s*)(lds + DP_TB); LAS bf16s* THR = (LAS bf16s*)(lds + DP_THR);
              f32x4 n10, n32;
#pragma unroll
              for (int ii = 0; ii < 4; ++ii) { n10[ii] = -t10[ii]; n32[ii] = -t32[ii];
                  TB[(16 + 4 * kq + ii) * 72 + r] = (bf16s)f2bf(n10[ii]); TB[(48 + 4 * kq + ii) * 72 + 32 + r] = (bf16s)f2bf(n32[ii]); THR[(16 + 4 * kq + ii) * 40 + r] = (bf16s)f2bf(n32[ii]); }
              *(LAS v2u*)(lds + DP_TLT + r * 80 + 32 + 8 * kq) = pack4(n10); }
            LDS_WAIT();
#pragma unroll
            for (int tn = 0; tn < 2; ++tn) { const bf16x8 bt = lds_frag(lds + DP_TLT + (16 * tn + r) * 80 + 16 * kq);
#pragma unroll
                for (int tm = 0; tm < 2; ++tm) { const f32x4 xa = __builtin_amdgcn_mfma_f32_16x16x32_bf16(al[tm], bt, (f32x4){0.f, 0.f, 0.f, 0.f}, 0, 0, 0);
                    *(LAS v2u*)(lds + DP_XT + (16 * tn + r) * 80 + 2 * (16 * tm + 4 * kq)) = pack4(xa); } }
            LDS_WAIT();
#pragma unroll
            for (int tm = 0; tm < 2; ++tm) { const bf16x8 ah = lds_frag(lds + DP_THR + (16 * tm + r) * 80 + 16 * kq);
#pragma unroll
                for (int tn = 0; tn < 2; ++tn) { const bf16x8 bx = lds_frag(lds + DP_XT + (16 * tn + r) * 80 + 16 * kq);
                    const f32x4 tl = __builtin_amdgcn_mfma_f32_16x16x32_bf16(ah, bx, (f32x4){0.f, 0.f, 0.f, 0.f}, 0, 0, 0);
#pragma unroll
                    for (int ii = 0; ii < 4; ++ii) ((LAS bf16s*)(lds + DP_TB))[(32 + 16 * tm + 4 * kq + ii) * 72 + 16 * tn + r] = (bf16s)f2bf(-tl[ii]); } }
        } else { PP_STAGE();
            const float Gl = Gs[63];
            for (int idx = (wave - 1) * 64 + lane; idx < 1536; idx += 448) { const int x = idx >> 9, e = idx & 127, tq = (idx >> 7) & 3;
                const LAS unsigned char* src = lds + (x == 0 ? DP_VR : DP_KR) + (16 * tq) * 272 + 2 * e; unsigned pk[8];
#pragma unroll
                for (int t2 = 0; t2 < 16; t2 += 2) { const int t0 = 16 * tq + t2;
                    const float g0 = Gs[t0], g1 = Gs[t0 + 1], b0 = Bs[t0], b1 = Bs[t0 + 1];
                    const float s0 = x == 0 ? b0 : (x == 1 ? b0 * __expf(g0) : __expf(Gl - g0)), s1 = x == 0 ? b1 : (x == 1 ? b1 * __expf(g1) : __expf(Gl - g1));
                    const float a0 = bflo((unsigned)*(const LAS bf16s*)(src + t2 * 272)), a1 = bflo((unsigned)*(const LAS bf16s*)(src + (t2 + 1) * 272));
                    pk[t2 >> 1] = pk2(a0 * s0, a1 * s1); }
                LAS unsigned char* dst = lds + (x == 0 ? DP_VBT : (x == 1 ? DP_KBGT : DP_KDT)) + e * 144 + 32 * tq;
                *(LAS v4u*)dst = (v4u){pk[0], pk[1], pk[2], pk[3]}; *(LAS v4u*)(dst + 16) = (v4u){pk[4], pk[5], pk[6], pk[7]}; }
        }
        BAR_L();
        { PP_STAGE(); const int itn = (it + istride < NIT) ? it + istride : it; PP_LOAD(pf, itn); }
        { PP_STAGE(); bf16x8 tf[4][2];
#pragma unroll
          for (int ti = 0; ti < 4; ++ti)
#pragma unroll
              for (int s = 0; s < 2; ++s) tf[ti][s] = lds_frag(lds + DP_TB + (16 * ti + r) * 144 + 64 * s + 16 * kq);
          bf16x8 vb[2], kb[2];
#pragma unroll
          for (int s = 0; s < 2; ++s) { vb[s] = lds_frag(lds + DP_VBT + (16 * wave + r) * 144 + 64 * s + 16 * kq); kb[s] = lds_frag(lds + DP_KBGT + (16 * wave + r) * 144 + 64 * s + 16 * kq); }
#pragma unroll
          for (int ti = 0; ti < 4; ++ti) { f32x4 au = {0.f, 0.f, 0.f, 0.f}, aw = {0.f, 0.f, 0.f, 0.f};
#pragma unroll
              for (int s = 0; s < 2; ++s) { au = __builtin_amdgcn_mfma_f32_16x16x32_bf16(tf[ti][s], vb[s], au, 0, 0, 0); aw = __builtin_amdgcn_mfma_f32_16x16x32_bf16(tf[ti][s], kb[s], aw, 0, 0, 0); }
              const int off = (16 * wave + r) * 144 + 2 * (16 * ti + 4 * kq);
              *(LAS v2u*)(lds + DP_UT + off) = pack4(au); *(LAS v2u*)(lds + DP_WT + off) = pack4(aw); } }
        BAR_L();
        { PP_STAGE();
        bf16x8 ua[2], wa[2];
#pragma unroll
        for (int s = 0; s < 2; ++s) { ua[s] = lds_frag(lds + DP_UT + (16 * wave + r) * 144 + 64 * s + 16 * kq); wa[s] = lds_frag(lds + DP_WT + (16 * wave + r) * 144 + 64 * s + 16 * kq); }
#pragma unroll
        for (int ti = 0; ti < 4; ++ti) { f32x4 ao = {0.f, 0.f, 0.f, 0.f}, aa = {0.f, 0.f, 0.f, 0.f};
#pragma unroll
            for (int s = 0; s < 2; ++s) { const bf16x8 at = lds_frag(lds + DP_ATT + (16 * ti + r) * 144 + 64 * s + 16 * kq);
                ao = __builtin_amdgcn_mfma_f32_16x16x32_bf16(ua[s], at, ao, 0, 0, 0); aa = __builtin_amdgcn_mfma_f32_16x16x32_bf16(wa[s], at, aa, 0, 0, 0); }
            const int i = 16 * ti + r; const float eg = __expf(Gs[i]); const size_t go = (size_t)(row0 + i) * 512 + h * 128 + 16 * wave + 4 * kq;
            const v2u qv = *(const LAS v2u*)(lds + DP_QR + i * 272 + 2 * (16 * wave + 4 * kq));
            *(v2u*)(OL + go) = pack4(ao);
            f32x4 qt; qt[0] = bflo(qv.x) * eg - aa[0]; qt[1] = bfhi(qv.x) * eg - aa[1]; qt[2] = bflo(qv.y) * eg - aa[2]; qt[3] = bfhi(qv.y) * eg - aa[3];
            *(v2u*)(QT + go) = pack4(qt); }
        { const float egl = __expf(Gs[63]); bf16* Mg = MC + (size_t)it * 32768; bf16* Cg = Mg + 16384;
          bf16x8 kda[2];
#pragma unroll
          for (int s = 0; s < 2; ++s) kda[s] = lds_frag(lds + DP_KDT + (16 * wave + r) * 144 + 64 * s + 16 * kq);
#pragma unroll
          for (int td = 0; td < 8; ++td) { f32x4 am = {0.f, 0.f, 0.f, 0.f}, ac = {0.f, 0.f, 0.f, 0.f};
#pragma unroll
              for (int s = 0; s < 2; ++s) { const bf16x8 kdb = lds_frag(lds + DP_KDT + (16 * td + r) * 144 + 64 * s + 16 * kq), ub = lds_frag(lds + DP_UT + (16 * td + r) * 144 + 64 * s + 16 * kq);
                  am = __builtin_amdgcn_mfma_f32_16x16x32_bf16(wa[s], kdb, am, 0, 0, 0);
                  ac = __builtin_amdgcn_mfma_f32_16x16x32_bf16(kda[s], ub, ac, 0, 0, 0); }
              const int dcol = 16 * td + r; f32x4 mm;
#pragma unroll
              for (int ii = 0; ii < 4; ++ii) { const int dp = 16 * wave + 4 * kq + ii; mm[ii] = ((dcol == dp) ? egl : 0.f) - am[ii]; }
              *(v2u*)(Mg + (size_t)dcol * 128 + 16 * wave + 4 * kq) = pack4(mm);
              *(v2u*)(Cg + (size_t)(16 * td + r) * 128 + 16 * wave + 4 * kq) = pack4(ac); } }
        }
        BAR_L();
    }
#undef PP_LOAD
}
constexpr int XT_ROW = 272, XT_BUF = 256 * XT_ROW, CB_Q = 2 * XT_BUF;
struct CbPf { v4u q0, q1; v2u ol[4]; bf16x8 ma[4]; v2u cc[8]; };
__device__ __forceinline__ void dn_combine_phase(const bf16* MC, const bf16* QT, const bf16* OL, bf16* QT2, bf16* OL2, bf16* MPC, LAS unsigned char* lds_, int item0, int istride, int tid_, int wave, int lane_) {
    for (int it = item0; it < 256; it += istride) {
        int tid = tid_, lane = lane_; LAS unsigned char* lds = lds_;
        asm volatile("" : "+v"(tid), "+v"(lane), "+v"(lds));
        const int r = lane & 15, kq = lane >> 4, h = it & 3, sc = (it >> 2) & 31, b = it >> 7, tt = tid >> 3, fb = tid & 7;
#define CB_LOAD(P, k_) do { const int n_ = 8 * sc + (k_); const bf16* Mg_ = MC + ((size_t)(b * 256 + n_) * 4 + h) * 32768; const size_t row0_ = (size_t)b * SEQ + (size_t)n_ * 64; \
            const bf16* qs_ = QT + (row0_ + tt) * 512 + h * 128 + 16 * fb; P.q0 = *(const v4u*)qs_; P.q1 = *(const v4u*)(qs_ + 8); \
            _Pragma("unroll") for (int ti = 0; ti < 4; ++ti) P.ol[ti] = *(const v2u*)(OL + (row0_ + 16 * ti + r) * 512 + h * 128 + 16 * wave + 4 * kq); \
            _Pragma("unroll") for (int s = 0; s < 4; ++s) P.ma[s] = *(const bf16x8*)(Mg_ + (16 * wave + r) * 128 + 32 * s + 8 * kq); \
            _Pragma("unroll") for (int c = 0; c < 8; ++c) P.cc[c] = *(const v2u*)(Mg_ + 16384 + (16 * c + r) * 128 + 16 * wave + 4 * kq); } while (0)
        CbPf pf; CB_LOAD(pf, 0);
        for (int i = tid; i < XT_BUF / 16; i += NWAVES * 64) ((LAS v4u*)lds)[i] = (v4u){0u, 0u, 0u, 0u};
        BAR_L();
        if (tid < 128) *(LAS bf16s*)(lds + tid * XT_ROW + 2 * tid) = (bf16s)0x3f80;
        for (int k = 0; k < 8; ++k) {
            const size_t row0 = (size_t)b * SEQ + (size_t)(8 * sc + k) * 64;
            const LAS unsigned char* xc = lds + (k & 1) * XT_BUF; LAS unsigned char* xn = lds + ((k + 1) & 1) * XT_BUF;
            CbPf cur = pf;
            *(LAS v4u*)(lds + CB_Q + tt * 272 + 32 * fb) = cur.q0; *(LAS v4u*)(lds + CB_Q + tt * 272 + 32 * fb + 16) = cur.q1;
            { const int kn = k < 7 ? k + 1 : 7; CB_LOAD(pf, kn); }
            BAR_L();
            { bf16x8 pa[4], da[4];
#pragma unroll
              for (int s = 0; s < 4; ++s) { pa[s] = lds_frag(xc + (16 * wave + r) * XT_ROW + 64 * s + 16 * kq); da[s] = lds_frag(xc + (128 + 16 * wave + r) * XT_ROW + 64 * s + 16 * kq); }
#pragma unroll
              for (int ti = 0; ti < 4; ++ti) { const size_t go = (row0 + 16 * ti + r) * 512 + h * 128 + 16 * wave + 4 * kq;
                  f32x4 aq = {0.f, 0.f, 0.f, 0.f}, ao = {bflo(cur.ol[ti].x), bfhi(cur.ol[ti].x), bflo(cur.ol[ti].y), bfhi(cur.ol[ti].y)};
#pragma unroll
                  for (int s = 0; s < 4; ++s) { const bf16x8 qb = lds_frag(lds + CB_Q + (16 * ti + r) * 272 + 64 * s + 16 * kq);
                      aq = __builtin_amdgcn_mfma_f32_16x16x32_bf16(pa[s], qb, aq, 0, 0, 0); ao = __builtin_amdgcn_mfma_f32_16x16x32_bf16(da[s], qb, ao, 0, 0, 0); }
                  *(v2u*)(QT2 + go) = pack4(aq); *(v2u*)(OL2 + go) = pack4(ao); } }
#pragma unroll
            for (int ct = 0; ct < 16; ++ct) { f32x4 a = {0.f, 0.f, 0.f, 0.f};
                if (ct >= 8) { const v2u cv = cur.cc[ct & 7]; a = (f32x4){bflo(cv.x), bfhi(cv.x), bflo(cv.y), bfhi(cv.y)}; }
#pragma unroll
                for (int s = 0; s < 4; ++s) a = __builtin_amdgcn_mfma_f32_16x16x32_bf16(cur.ma[s], lds_frag(xc + (16 * ct + r) * XT_ROW + 64 * s + 16 * kq), a, 0, 0, 0);
                *(LAS v2u*)(xn + (16 * ct + r) * XT_ROW + 2 * (16 * wave + 4 * kq)) = pack4(a); }
            BAR_L();
        }
#undef CB_LOAD
        { bf16* Mo = MPC + (size_t)it * 32768;
          for (int i = tid; i < 2048; i += NWAVES * 64) { const int dd = i & 127, db = i >> 7; unsigned pk[4];
#pragma unroll
              for (int j = 0; j < 8; j += 2) pk[j >> 1] = (unsigned)*(const LAS bf16s*)(lds + (8 * db + j) * XT_ROW + 2 * dd) | ((unsigned)*(const LAS bf16s*)(lds + (8 * db + j + 1) * XT_ROW + 2 * dd) << 16);
              *(v4u*)(Mo + (size_t)dd * 128 + 8 * db) = (v4u){pk[0], pk[1], pk[2], pk[3]}; }
          for (int i = tid; i < 2048; i += NWAVES * 64) { const int e = i >> 4, c8 = i & 15; *(v4u*)(Mo + 16384 + (size_t)e * 128 + 8 * c8) = *(const LAS v4u*)(lds + (128 + e) * XT_ROW + 16 * c8); } }
        BAR_L();
    }
}
struct DnOp { bf16x8 ma[4]; v2u cc; };
__device__ __forceinline__ void dn_scan_phase(const bf16* MPC, bf16* SST, LAS unsigned char* lds, int bx, int wave, int lane) {
    const int tidx = wave * 64 + lane;
    const int r = lane & 15, kq = lane >> 4, bh = bx & 7, b = bh >> 2, h = bh & 3, e0 = 16 * (bx >> 3);
    for (int i = tidx; i < 2 * 16 * 272 / 4; i += NWAVES * 64) ((LAS unsigned*)lds)[i] = 0u;
    __syncthreads();
#define DN_LOAD(X, n_) do { const int nn = (n_) < 32 ? (n_) : 31; const bf16* Mg = MPC + (size_t)((b * 32 + nn) * 4 + h) * 32768; \
        _Pragma("unroll") for (int s = 0; s < 4; ++s) X.ma[s] = *(const bf16x8*)(Mg + (16 * wave + r) * 128 + 32 * s + 8 * kq); \
        X.cc = *(const v2u*)(Mg + 16384 + (e0 + r) * 128 + 16 * wave + 4 * kq); } while (0)
#define DN_STEP(X, n_) do { const LAS unsigned char* stc = lds + ((n_) & 1) * (16 * 272); LAS unsigned char* stn = lds + (((n_) + 1) & 1) * (16 * 272); \
        bf16x8 sb[4]; \
        _Pragma("unroll") for (int s = 0; s < 4; ++s) sb[s] = lds_frag(stc + r * 272 + 64 * s + 16 * kq); \
        { const int t = tidx, e = t >> 5, c4 = t & 31; *(v2u*)(SST + (size_t)((b * 32 + (n_)) * 4 + h) * 16384 + (size_t)(e0 + e) * 128 + 4 * c4) = *(const LAS v2u*)(stc + e * 272 + 8 * c4); } \
        f32x4 as = {bflo(X.cc.x), bfhi(X.cc.x), bflo(X.cc.y), bfhi(X.cc.y)}; \
        _Pragma("unroll") for (int s = 0; s < 4; ++s) as = __builtin_amdgcn_mfma_f32_16x16x32_bf16(X.ma[s], sb[s], as, 0, 0, 0); \
        *(LAS v2u*)(stn + r * 272 + 2 * (16 * wave + 4 * kq)) = pack4(as); \
        asm volatile("s_waitcnt lgkmcnt(0)" ::: "memory"); __builtin_amdgcn_s_barrier(); asm volatile("" ::: "memory"); } while (0)
    DnOp A, B, Cc, Dd;
    DN_LOAD(A, 0); DN_LOAD(B, 1); DN_LOAD(Cc, 2);
    for (int n = 0; n < 32; n += 4) {
        DN_LOAD(Dd, n + 3); DN_STEP(A, n);
        DN_LOAD(A, n + 4);  DN_STEP(B, n + 1);
        DN_LOAD(B, n + 5);  DN_STEP(Cc, n + 2);
        DN_LOAD(Cc, n + 6); DN_STEP(Dd, n + 3);
    }
#undef DN_LOAD
#undef DN_STEP
    asm volatile("s_waitcnt vmcnt(0)" ::: "memory");
    __syncthreads();
}
constexpr int OP_Q = 128 * 272, OP_SS = OP_Q + 64 * 272;
struct OpPf { v4u q0, q1; v2u ol[4], z[4]; };
__device__ __forceinline__ void dn_out_phase(const bf16* SST, const bf16* QT2, const bf16* OL2, const bf16* Z, const float* on_g, bf16* YCAT, LAS unsigned char* lds_, int item0, int istride, int tid_, int wave, int lane_) {
    for (int it = item0; it < 256; it += istride) {
        int tid = tid_, lane = lane_; LAS unsigned char* lds = lds_;
        asm volatile("" : "+v"(tid), "+v"(lane), "+v"(lds));
        const int r = lane & 15, kq = lane >> 4, h = it & 3, sc = (it >> 2) & 31, b = it >> 7, tt = tid >> 3, fb = tid & 7;
        LAS float* ss = (LAS float*)(lds + OP_SS);
#define OP_LOAD(P, k_) do { const size_t row0_ = (size_t)b * SEQ + (size_t)(8 * sc + (k_)) * 64; \
            const bf16* qs_ = QT2 + (row0_ + tt) * 512 + h * 128 + 16 * fb; P.q0 = *(const v4u*)qs_; P.q1 = *(const v4u*)(qs_ + 8); \
            _Pragma("unroll") for (int ti = 0; ti < 4; ++ti) { const size_t go_ = (row0_ + 16 * ti + r) * 512 + h * 128 + 16 * wave + 4 * kq; P.ol[ti] = *(const v2u*)(OL2 + go_); P.z[ti] = *(const v2u*)(Z + go_); } } while (0)
        OpPf pf; OP_LOAD(pf, 0);
        { const bf16* Sg = SST + (size_t)it * 16384;
          for (int i = tid; i < 2048; i += NWAVES * 64) { const int e = i >> 4, c8 = i & 15; *(LAS v4u*)(lds + e * 272 + 16 * c8) = *(const v4u*)(Sg + (size_t)e * 128 + 8 * c8); } }
        BAR_L();
        bf16x8 sa[4];
#pragma unroll
        for (int s = 0; s < 4; ++s) sa[s] = lds_frag(lds + (16 * wave + r) * 272 + 64 * s + 16 * kq);
        const f32x4 gn = *(const f32x4*)(on_g + 16 * wave + 4 * kq);
        for (int k = 0; k < 8; ++k) {
            const size_t row0 = (size_t)b * SEQ + (size_t)(8 * sc + k) * 64;
            OpPf cur = pf;
            *(LAS v4u*)(lds + OP_Q + tt * 272 + 32 * fb) = cur.q0; *(LAS v4u*)(lds + OP_Q + tt * 272 + 32 * fb + 16) = cur.q1;
            { const int kn = k < 7 ? k + 1 : 7; OP_LOAD(pf, kn); }
            BAR_L();
            f32x4 o[4];
#pragma unroll
            for (int ti = 0; ti < 4; ++ti) { f32x4 a = {bflo(cur.ol[ti].x), bfhi(cur.ol[ti].x), bflo(cur.ol[ti].y), bfhi(cur.ol[ti].y)};
#pragma unroll
                for (int s = 0; s < 4; ++s) a = __builtin_amdgcn_mfma_f32_16x16x32_bf16(sa[s], lds_frag(lds + OP_Q + (16 * ti + r) * 272 + 64 * s + 16 * kq), a, 0, 0, 0);
                o[ti] = a; float t = a[0] * a[0] + a[1] * a[1] + a[2] * a[2] + a[3] * a[3];
                t += __shfl_xor(t, 16); t += __shfl_xor(t, 32);
                if (kq == 0) ss[((k & 1) * 64 + 16 * ti + r) * 8 + wave] = t; }
            BAR_L();
#pragma unroll
            for (int ti = 0; ti < 4; ++ti) { const LAS f32x4* sp = (const LAS f32x4*)(ss + ((k & 1) * 64 + 16 * ti + r) * 8); const f32x4 s0 = sp[0], s1 = sp[1];
                const float ms = ((s0[0] + s0[1]) + (s0[2] + s0[3])) + ((s1[0] + s1[1]) + (s1[2] + s1[3]));
                const float rs = rsqrtf(ms * (1.f / 128.f) + 1e-6f); const v2u zv = cur.z[ti];
                f32x4 y; y[0] = o[ti][0] * rs * gn[0] * bflo(zv.x); y[1] = o[ti][1] * rs * gn[1] * bfhi(zv.x); y[2] = o[ti][2] * rs * gn[2] * bflo(zv.y); y[3] = o[ti][3] * rs * gn[3] * bfhi(zv.y);
                *(v2u*)(YCAT + (row0 + 16 * ti + r) * D + 512 + h * 128 + 16 * wave + 4 * kq) = pack4(y); }
        }
#undef OP_LOAD
        BAR_L();
    }
}
#endif
struct Args { const float* in[22]; float* out; unsigned char* ws; int ph, one, pad0, pad1; };
struct Ctx { int wave, G, bx, vcu, gw, NGW; };
#define RUN() (one || p == args.ph)
#define SEAM() do { if (one) xcd_barrier(bar); ++p; } while (0)
#define SKIP() do { ++p; } while (0)
#define WSP(T, off) ((T*)(ws + (off)))
#ifndef DUP
#define DUP 0
#endif
#define REP(bit) for (int _r = 0; _r < 1 + ((DUP >> (bit)) & 1); ++_r)
#define REPSYNC(bit) do { if (_r == 0 && ((DUP >> (bit)) & 1)) __syncthreads(); } while (0)

template <int L> __device__ __forceinline__ void layer_mixer(const Args& args, LAS unsigned char* lds, const XcdBarrier& bar, const bool one, int& p, const Ctx& C) {
    unsigned char* ws = args.ws;
    if (RUN()) REP(1) {
        pg8::Gemm g{WSP(const bf16, WS_XB), WSP(const bf16, WS_WIN) + (size_t)L * NIN * 1024, M, NIN, D}; pg8::StaticOrder S; S.init(M, NIN, C.G, C.bx);
        pg8::EpiInProj E{WSP(bf16, WS_GLU), WSP(bf16, WS_QKV), WSP(bf16, WS_Z)};
        pg8::gemm_phase<pg8::EpiInProj, pg8::StaticOrder, true, true>(lds, g, S, E, C.wave);
        gates_phase(WSP(const bf16, WS_XB), WSP(const bf16, WS_WGT) + (size_t)L * 16 * 1024, WSP(float, WS_G8), C.gw, C.NGW, lane_id()); REPSYNC(1);
    }
    SEAM();
#if DN_NAIVE
    if (RUN()) {
        conv_phase(WSP(const bf16, WS_GLU), WSP(bf16, WS_YCAT), args.in[2] + (size_t)L * 31 * 512, args.in[3] + L * 512, args.in[4] + L * 512, args.in[5] + L * 512, lds, C.vcu, C.G, C.wave, lane_id());
        dnpre_phase(WSP(const bf16, WS_QKV), WSP(bf16, WS_QKVN), WSP(const float, WS_G8), WSP(float, WS_GB), WSP(float, WS_GG), args.in[6] + (size_t)L * 4 * 1536, args.in[7] + L * 4, args.in[8] + L * 4, C.gw, C.NGW, lane_id());
    }
    SEAM();
#else
    SKIP();
#endif
#if DN_NAIVE
    if (RUN()) { if (C.wave == 0 && C.vcu < 256) dn_naive_phase(WSP(const bf16, WS_QKVN), WSP(const float, WS_GB), WSP(const float, WS_GG), WSP(bf16, WS_OL), C.vcu, lane_id()); }
    SEAM();
    SKIP();
    SKIP();
    if (RUN()) dnnorm_phase(WSP(const bf16, WS_OL), WSP(const bf16, WS_Z), args.in[9] + L * 128, WSP(bf16, WS_YCAT), C.gw, C.NGW, lane_id());
    SEAM();
#else
    if (RUN()) {
        REP(2) { conv_phase(WSP(const bf16, WS_GLU), WSP(bf16, WS_YCAT), args.in[2] + (size_t)L * 31 * 512, args.in[3] + L * 512, args.in[4] + L * 512, args.in[5] + L * 512, lds, C.vcu, C.G, C.wave, lane_id()); __syncthreads(); }
        REP(4) dn_prep_phase(WSP(const bf16, WS_QKV), WSP(const float, WS_G8), args.in[6] + (size_t)L * 4 * 1536, args.in[7] + L * 4, args.in[8] + L * 4, WSP(bf16, WS_OL), WSP(bf16, WS_QT), WSP(bf16, WS_MC), lds, C.vcu, C.G, (C.wave * 64 + lane_id()), C.wave, lane_id());
    }
    SEAM();
    if (RUN()) REP(12) dn_combine_phase(WSP(const bf16, WS_MC), WSP(const bf16, WS_QT), WSP(const bf16, WS_OL), WSP(bf16, WS_QT2), WSP(bf16, WS_OL2), WSP(bf16, WS_MPC), lds, C.vcu, C.G, (C.wave * 64 + lane_id()), C.wave, lane_id());
    SEAM();
    if (RUN()) { if (C.bx < 64) REP(5) dn_scan_phase(WSP(const bf16, WS_MPC), WSP(bf16, WS_SST), lds, C.bx, C.wave, lane_id()); }
    SEAM();
    if (RUN()) REP(6) dn_out_phase(WSP(const bf16, WS_SST), WSP(const bf16, WS_QT2), WSP(const bf16, WS_OL2), WSP(const bf16, WS_Z), args.in[9] + L * 128, WSP(bf16, WS_YCAT), lds, C.vcu, C.G, (C.wave * 64 + lane_id()), C.wave, lane_id());
    SEAM();
#endif
    if (RUN()) {
        pg8::Gemm g{WSP(const bf16, WS_YCAT), WSP(const bf16, WS_WOUT) + (size_t)L * 1024 * 1024, M, D, D}; pg8::StaticOrder S; S.init(M, D, C.G, C.bx);
        pg8::EpiResid E{L == 0 ? args.in[0] : (const float*)args.out, args.out, ALPHA};
        pg8::gemm_phase<pg8::EpiResid, pg8::StaticOrder, true, true>(lds, g, S, E, C.wave);
    }
    SEAM();
}

__global__ void __launch_bounds__(NWAVES * 64, 2) fwd_kernel(Args args) {
    extern __shared__ __attribute__((aligned(16))) unsigned char lds_raw[];
    LAS unsigned char* lds = (LAS unsigned char*)lds_raw;
    volatile LAS unsigned* MISC = (volatile LAS unsigned*)(lds + MISC_OFF);
    Ctx C;
    C.wave = __builtin_amdgcn_readfirstlane((int)threadIdx.x >> 6);
    C.G = gridDim.x; C.bx = blockIdx.x; C.vcu = (C.G % 8 == 0) ? (C.bx % 8) * (C.G / 8) + C.bx / 8 : C.bx;
    C.gw = C.vcu * NWAVES + C.wave; C.NGW = C.G * NWAVES;
    unsigned char* ws = args.ws;
    unsigned* ctl = (unsigned*)(ws + WS_CTL);
    for (int u = threadIdx.x; u < (LDS_BYTES - LDSCTL_OFF) / 4; u += NWAVES * 64) ((LAS unsigned*)(lds + LDSCTL_OFF))[u] = 0u;
    __syncthreads();
    const bool one = args.one != 0;
    XcdBarrier bar; bar.bar = ctl + CW_BAR; bar.x = 0; bar.st = nullptr;
    if (one) bar = xcd_barrier_post(ctl + CW_BAR, MISC + 8);
    int p = 0;

    if (RUN()) REP(0) { prologue_phase(args.in[0], args.in[1], args.in[10], args.in[13], args.in[14], args.in[15], ws, lds, C.gw, C.NGW, C.wave, lane_id()); REPSYNC(0); }
    SEAM();

    layer_mixer<0>(args, lds, bar, one, p, C);
    if (RUN()) ln_phase(args.out, WSP(bf16, WS_XB), args.in[11], args.in[12], C.gw, C.NGW, lane_id());
    SEAM();
    if (RUN()) REP(7) {
        pg8::Gemm g{WSP(const bf16, WS_XB), WSP(const bf16, WS_WGU0), M, 2 * FF0, D}; pg8::StaticOrder S; S.init(M, 2 * FF0, C.G, C.bx);
        pg8::EpiSwiGLU E{WSP(bf16, WS_HID0), FF0};
        pg8::gemm_phase<pg8::EpiSwiGLU, pg8::StaticOrder, true, true>(lds, g, S, E, C.wave); REPSYNC(7);
    }
    SEAM();
    if (RUN()) {
        pg8::Gemm g{WSP(const bf16, WS_HID0), WSP(const bf16, WS_WD0), M, D, FF0}; pg8::StaticOrder S; S.init(M, D, C.G, C.bx);
        pg8::EpiResid E{(const float*)args.out, args.out, ALPHA};
        pg8::gemm_phase<pg8::EpiResid, pg8::StaticOrder, true, true>(lds, g, S, E, C.wave);
    }
    SEAM();
    if (RUN()) ln_phase(args.out, WSP(bf16, WS_XB), args.in[20], args.in[21], C.gw, C.NGW, lane_id());
    SEAM();
    SKIP();

    layer_mixer<1>(args, lds, bar, one, p, C);
    if (RUN()) {
        ln_router_phase(args.out, WSP(bf16, WS_XB), args.in[11] + D, args.in[12] + D, args.in[16], WSP(int4, WS_RI), WSP(f32x2, WS_RG), WSP(int, WS_COUNTS), lds, C.vcu, (C.wave * 64 + lane_id()), C.wave, lane_id());
        REP(8) moe_convert_phase(args.in[17], args.in[18], args.in[19], ws, lds, C.gw, C.NGW, C.wave, lane_id());
    }
    SEAM();
    if (RUN()) REP(9) moe_gather_phase(WSP(const bf16, WS_XB), WSP(bf16, WS_XG), WSP(const int4, WS_RI), WSP(int2, WS_POS), WSP(const int, WS_COUNTS), WSP(int, WS_META), lds, C.vcu, (C.wave * 64 + lane_id()), C.wave, lane_id());
    SEAM();
    for (int c = 0; c < 5; ++c) {
        asm volatile("" : "+s"(ws));
        int* META = WSP(int, WS_META);
        int tb[9];
#pragma unroll
        for (int e = 0; e < 9; ++e) tb[e] = __builtin_amdgcn_readfirstlane(__hip_atomic_load(META + e, __ATOMIC_RELAXED, __HIP_MEMORY_SCOPE_AGENT)) >> 8;
        const int T = tb[8], t0 = 64 * c, nt = (T - t0) < 64 ? (T - t0) : 64;
        if (RUN() && nt > 0) REP(10) {
            pg8::MoeOrder<0> S; S.nM = nt; S.nN = 28; S.nwg = nt * 28; S.G = C.G; S.c = C.bx; S.t0 = t0; S.tb1 = tb[1]; S.tb2 = tb[2]; S.tb3 = tb[3]; S.tb4 = tb[4]; S.tb5 = tb[5]; S.tb6 = tb[6]; S.tb7 = tb[7];
            pg8::Gemm g{WSP(const bf16, WS_XG), WSP(const bf16, WS_WMGU), 0, 0, D};
            pg8::EpiSwiGLU E{WSP(bf16, WS_HIDM), FFE};
            pg8::gemm_phase<pg8::EpiSwiGLU, pg8::MoeOrder<0>, true, true>(lds, g, S, E, C.wave); REPSYNC(10);
        }
        if (nt > 0) SEAM(); else SKIP();
        if (RUN() && nt > 0) REP(11) {
            pg8::MoeOrder<1> S; S.nM = nt; S.nN = 4; S.nwg = nt * 4; S.G = C.G; S.c = C.bx; S.t0 = t0; S.tb1 = tb[1]; S.tb2 = tb[2]; S.tb3 = tb[3]; S.tb4 = tb[4]; S.tb5 = tb[5]; S.tb6 = tb[6]; S.tb7 = tb[7];
            pg8::Gemm g{WSP(const bf16, WS_HIDM), WSP(const bf16, WS_WMD), 0, 0, FFE};
            pg8::EpiBf16 E{WSP(bf16, WS_XG), D};
            pg8::gemm_phase<pg8::EpiBf16, pg8::MoeOrder<1>, true, true>(lds, g, S, E, C.wave); REPSYNC(11);
        }
        if (nt > 0) SEAM(); else SKIP();
    }
    if (RUN()) moe_combine_phase(args.out, WSP(const bf16, WS_XG), WSP(const int2, WS_POS), WSP(const f32x2, WS_RG), args.in[20] + D, args.in[21] + D, C.gw, C.NGW, lane_id());
}
#undef RUN
#undef SEAM
#undef SKIP

extern "C" void kernel_launch(void* const* d_in, const int* in_sizes, int n_in, void* d_out, int out_size, void* d_ws, size_t ws_size, hipStream_t stream) {
    static int grid = 0;
    if (grid == 0) {
        if (n_in != 22 || in_sizes[0] != M * D || out_size != M * D || ws_size < WS_END) { fprintf(stderr, "kernel_launch: unexpected shapes / workspace (n_in %d, ws %zu < %zu); nothing launched\n", n_in, ws_size, (size_t)WS_END); grid = -1; return; }
        int dev = 0, cus = 0;
        if (hipGetDevice(&dev) != hipSuccess || hipDeviceGetAttribute(&cus, hipDeviceAttributeMultiprocessorCount, dev) != hipSuccess) { grid = -1; return; }
        if (hipFuncSetAttribute((const void*)fwd_kernel, hipFuncAttributeMaxDynamicSharedMemorySize, LDS_BYTES) != hipSuccess) { fprintf(stderr, "kernel_launch: hipFuncSetAttribute failed\n"); grid = -1; return; }
        (void)hipGetLastError();
        if (cus != 256) { fprintf(stderr, "kernel_launch: built for 256 CUs, device has %d; nothing launched\n", cus); grid = -1; return; }
        grid = cus;
    }
    if (grid < 0) return;
    if (hipMemsetAsync((char*)d_ws + WS_CTL, 0, CTL_ZERO_BYTES, stream) != hipSuccess) return;
    Args a{};
    for (int i = 0; i < 22; ++i) a.in[i] = (const float*)d_in[i];
    a.out = (float*)d_out; a.ws = (unsigned char*)d_ws;
#if MK_N_LAUNCHES == 1
    a.ph = 0; a.one = 1;
    hipLaunchKernelGGL(fwd_kernel, dim3(grid), dim3(NWAVES * 64), LDS_BYTES, stream, a);
#else
    for (int ph = 0; ph < NPH; ++ph) { a.ph = ph; a.one = 0; hipLaunchKernelGGL(fwd_kernel, dim3(grid), dim3(NWAVES * 64), LDS_BYTES, stream, a); }
#endif
}
```
